# Optimizing an MI355X kernel written in HIP

```python
import jax, jax.numpy as jnp
from jax import lax
import numpy as np

D_MODEL = 1024
BATCH = 16
SEQ = 4096
DEPTH = 1
DEC_BATCH = 32
DEC_SEQ = 64
PAST_LEN = 2048

CHUNK = 64
GMLP_CHUNK = 128
GMLP_WIDTH = 1024
GMLP_GROUPS = 8
GMLP_GROUP_DIM = GMLP_WIDTH // GMLP_GROUPS
N_HEADS = 16
N_KV_HEADS = 4
GQA_GROUP = N_HEADS // N_KV_HEADS
HEAD_DIM = 64
ATTN_WIDTH = N_HEADS * HEAD_DIM
KV_WIDTH = N_KV_HEADS * HEAD_DIM
WINDOW = 128
WIN_CHUNKS = WINDOW // CHUNK
D_FF = 2816
CONV_W = 3
EPS = 1e-6
NEG_INF = -1e30
SPLITS = [GMLP_WIDTH, 2 * GMLP_WIDTH, 2 * GMLP_WIDTH + ATTN_WIDTH,
          2 * GMLP_WIDTH + ATTN_WIDTH + KV_WIDTH, 2 * GMLP_WIDTH + ATTN_WIDTH + 2 * KV_WIDTH]
IN_COLS = 2 * GMLP_WIDTH + ATTN_WIDTH + 2 * KV_WIDTH + 2 * D_MODEL

kernel_name = 'hybrid_gmlp_swa_convffn_stream_step'


def rms_norm(x, g):
    xf = x.astype(jnp.float32)
    y = xf * lax.rsqrt(jnp.mean(xf * xf, axis=-1, keepdims=True) + EPS)
    return (y * g.astype(jnp.float32)).astype(x.dtype)


def layer_norm(x, g, b):
    xf = x.astype(jnp.float32)
    mu = jnp.mean(xf, axis=-1, keepdims=True)
    xc = xf - mu
    y = xc * lax.rsqrt(jnp.mean(xc * xc, axis=-1, keepdims=True) + EPS)
    return (y * g.astype(jnp.float32) + b.astype(jnp.float32)).astype(x.dtype)


def alibi_slopes():
    return jnp.exp2(-8.0 * jnp.arange(1, N_HEADS + 1, dtype=jnp.float32) / N_HEADS)


def gmlp_spatial(u, vn, w_s, b_s):
    B, S, _ = u.shape
    L = min(S, GMLP_CHUNK)
    nc = S // L
    idx = jnp.arange(L)
    mask = (idx[None, :] // CHUNK) <= (idx[:, None] // CHUNK)
    w = w_s[:, :L, :L] * mask[None].astype(w_s.dtype)
    vg = vn.reshape(B, nc, L, GMLP_GROUPS, GMLP_GROUP_DIM)
    s = jnp.einsum('gts,bnsgc->bntgc', w, vg) + b_s[:, :L].T[None, None, :, :, None]
    return u * s.reshape(B, S, GMLP_WIDTH)


def sink_attend(qc, kb, vb, dist, valid, sinks):
    s = jnp.einsum('bnqhgd,bnshd->bnhgqs', qc, kb).astype(jnp.float32) * (HEAD_DIM ** -0.5)
    slopes = alibi_slopes().reshape(N_KV_HEADS, GQA_GROUP, 1, 1)
    s = jnp.where(valid, s - slopes * dist.astype(jnp.float32), NEG_INF)
    sink = sinks.astype(jnp.float32).reshape(N_KV_HEADS, GQA_GROUP, 1, 1)
    m = jnp.maximum(jnp.max(s, axis=-1, keepdims=True), sink)
    e = jnp.exp(s - m)
    p = e / (jnp.sum(e, axis=-1, keepdims=True) + jnp.exp(sink - m))
    return jnp.einsum('bnhgqs,bnshd->bnqhgd', p.astype(vb.dtype), vb)


def swa_prompt(q, k, v, sinks):
    B, S = q.shape[0], q.shape[1]
    nc = S // CHUNK
    nb = WIN_CHUNKS + 1
    pad = ((0, 0), (WINDOW, 0), (0, 0), (0, 0))
    kc = jnp.pad(k, pad).reshape(B, nc + WIN_CHUNKS, CHUNK, N_KV_HEADS, HEAD_DIM)
    vc = jnp.pad(v, pad).reshape(B, nc + WIN_CHUNKS, CHUNK, N_KV_HEADS, HEAD_DIM)
    kb = jnp.concatenate([kc[:, i:i + nc] for i in range(nb)], axis=2)
    vb = jnp.concatenate([vc[:, i:i + nc] for i in range(nb)], axis=2)
    qc = q.reshape(B, nc, CHUNK, N_KV_HEADS, GQA_GROUP, HEAD_DIM)
    qi = jnp.arange(CHUNK)
    kj = jnp.arange(nb * CHUNK)
    dist = jnp.abs(qi[:, None] + WINDOW - kj[None, :])
    kpos = jnp.arange(nc)[:, None] * CHUNK - WINDOW + kj[None, :]
    valid = (kpos >= 0)[None, :, None, None, None, :]
    o = sink_attend(qc, kb, vb, dist, valid, sinks)
    return o.reshape(B, S, ATTN_WIDTH)


def swa_sample(q, k, v, cache_k, cache_v, sinks):
    B, n = q.shape[0], q.shape[1]
    w = cache_k.shape[1]
    kb = jnp.concatenate([cache_k, k], axis=1)[:, None]
    vb = jnp.concatenate([cache_v, v], axis=1)[:, None]
    qc = q.reshape(B, 1, n, N_KV_HEADS, GQA_GROUP, HEAD_DIM)
    dist = jnp.abs(jnp.arange(n)[:, None] + w - jnp.arange(w + n)[None, :])
    valid = jnp.ones((w + n,), dtype=bool)
    o = sink_attend(qc, kb, vb, dist, valid, sinks)
    return o.reshape(B, n, ATTN_WIDTH)


def conv_ffn(h, w_up, w_conv, b_conv, w_down, conv_state):
    B, S, _ = h.shape
    up = h @ w_up
    a, val = jnp.split(up, 2, axis=-1)
    hist = jnp.zeros((B, CONV_W - 1, D_FF), a.dtype) if conv_state is None else conv_state
    a_ext = jnp.concatenate([hist, a], axis=1)
    c = b_conv + sum(w_conv[i] * a_ext[:, i:i + S] for i in range(CONV_W))
    out = (jax.nn.gelu(c) * val) @ w_down
    return out, a_ext[:, -(CONV_W - 1):]


def trunk(x, params, caches):
    (ln_mix_g, w_in, ln_v_g, ln_v_b, w_s, b_s, attn_sinks, w_pa, w_pb, w_o,
     ln_ffn_g, w_up, w_conv, b_conv, w_down, ln_final_g) = params
    B, S, _ = x.shape
    new_k, new_v, new_conv, new_gv = [], [], [], []
    for l in range(DEPTH):
        h = rms_norm(x, ln_mix_g[l])
        proj = h @ w_in[l]
        u, vg, q, k, v, gates = jnp.split(proj, SPLITS, axis=-1)
        vn = layer_norm(jax.nn.gelu(vg), ln_v_g[l], ln_v_b[l])
        a_out = gmlp_spatial(jax.nn.gelu(u), vn, w_s[l], b_s[l])
        q = q.reshape(B, S, N_HEADS, HEAD_DIM)
        k = k.reshape(B, S, N_KV_HEADS, HEAD_DIM)
        v = v.reshape(B, S, N_KV_HEADS, HEAD_DIM)
        if caches is None:
            b_out = swa_prompt(q, k, v, attn_sinks[l])
            keep = min(WINDOW, S)
            new_k.append(k[:, S - keep:])
            new_v.append(v[:, S - keep:])
            conv_state = None
        else:
            b_out = swa_sample(q, k, v, caches[0][l], caches[1][l], attn_sinks[l])
            new_k.append(k)
            new_v.append(v)
            new_gv.append(vn)
            conv_state = caches[2][l]
        gate_a, gate_b = jnp.split(jax.nn.sigmoid(gates), 2, axis=-1)
        merged = gate_a * (a_out @ w_pa[l]) + gate_b * (b_out @ w_pb[l])
        x = x + merged @ w_o[l]
        f, conv_new = conv_ffn(rms_norm(x, ln_ffn_g[l]), w_up[l], w_conv[l], b_conv[l], w_down[l], conv_state)
        new_conv.append(conv_new)
        x = x + f
    y = rms_norm(x, ln_final_g)
    gv = jnp.stack(new_gv) if caches is not None else None
    return y, jnp.stack(new_k), jnp.stack(new_v), jnp.stack(new_conv), gv


def setup_inputs(seed: int = 0) -> dict:
    key = jax.random.key(seed)
    ks = jax.random.split(key, 24)
    f32 = jnp.float32
    rows = min(WINDOW, PAST_LEN)
    nrm = lambda k, shape, s: jax.random.normal(k, shape, f32) * s
    return {
        'x_prompt': nrm(ks[0], (BATCH, SEQ, D_MODEL), 1.0),
        'x_sample': nrm(ks[1], (DEC_BATCH, DEC_SEQ, D_MODEL), 1.0),
        'cache_k': nrm(ks[2], (DEPTH, DEC_BATCH, rows, N_KV_HEADS, HEAD_DIM), 1.0),
        'cache_v': nrm(ks[3], (DEPTH, DEC_BATCH, rows, N_KV_HEADS, HEAD_DIM), 1.0),
        'cache_conv': nrm(ks[4], (DEPTH, DEC_BATCH, CONV_W - 1, D_FF), 1.0),
        'ln_mix_g': 1.0 + nrm(ks[5], (DEPTH, D_MODEL), 0.02),
        'w_in': nrm(ks[6], (DEPTH, D_MODEL, IN_COLS), D_MODEL ** -0.5),
        'ln_v_g': 1.0 + nrm(ks[7], (DEPTH, GMLP_WIDTH), 0.02),
        'ln_v_b': nrm(ks[8], (DEPTH, GMLP_WIDTH), 0.02),
        'w_s': nrm(ks[9], (DEPTH, GMLP_GROUPS, GMLP_CHUNK, GMLP_CHUNK), GMLP_CHUNK ** -0.5),
        'b_s': 1.0 + nrm(ks[10], (DEPTH, GMLP_GROUPS, GMLP_CHUNK), 0.1),
        'attn_sinks': nrm(ks[11], (DEPTH, N_HEADS), 0.5),
        'w_pa': nrm(ks[12], (DEPTH, GMLP_WIDTH, D_MODEL), GMLP_WIDTH ** -0.5),
        'w_pb': nrm(ks[13], (DEPTH, ATTN_WIDTH, D_MODEL), ATTN_WIDTH ** -0.5),
        'w_o': nrm(ks[14], (DEPTH, D_MODEL, D_MODEL), D_MODEL ** -0.5),
        'ln_ffn_g': 1.0 + nrm(ks[15], (DEPTH, D_MODEL), 0.02),
        'w_up': nrm(ks[16], (DEPTH, D_MODEL, 2 * D_FF), D_MODEL ** -0.5),
        'w_conv': nrm(ks[17], (DEPTH, CONV_W, D_FF), CONV_W ** -0.5),
        'b_conv': nrm(ks[18], (DEPTH, D_FF), 0.02),
        'w_down': nrm(ks[19], (DEPTH, D_FF, D_MODEL), D_FF ** -0.5),
        'ln_final_g': 1.0 + nrm(ks[20], (D_MODEL,), 0.02),
    }


def reference(x_prompt, x_sample, cache_k, cache_v, cache_conv, ln_mix_g, w_in, ln_v_g, ln_v_b,
              w_s, b_s, attn_sinks, w_pa, w_pb, w_o, ln_ffn_g, w_up, w_conv, b_conv, w_down, ln_final_g):
    params = (ln_mix_g, w_in, ln_v_g, ln_v_b, w_s, b_s, attn_sinks, w_pa, w_pb, w_o,
              ln_ffn_g, w_up, w_conv, b_conv, w_down, ln_final_g)
    y_prompt, new_k_prompt, new_v_prompt, new_conv_prompt, _ = trunk(x_prompt, params, None)
    y_sample, new_k_sample, new_v_sample, new_conv_sample, new_gmlp_v_sample = trunk(
        x_sample, params, (cache_k, cache_v, cache_conv))
    return (y_prompt, y_sample, new_k_prompt, new_v_prompt, new_conv_prompt,
            new_k_sample, new_v_sample, new_conv_sample, new_gmlp_v_sample)
```

```cpp
#include <hip/hip_runtime.h>
#include <hip/hip_cooperative_groups.h>
#include <cstdio>
#include <cstdint>
namespace cg = cooperative_groups;

#ifndef MK_ONE_LAUNCH
#define MK_ONE_LAUNCH 1
#endif

#define LAS3 __attribute__((address_space(3)))
typedef unsigned short bf16_t;
typedef short bf16x8 __attribute__((ext_vector_type(8)));
typedef short s16x4 __attribute__((ext_vector_type(4)));
typedef float f32x4 __attribute__((ext_vector_type(4)));
typedef float f32x16 __attribute__((ext_vector_type(16)));
typedef unsigned u32x4 __attribute__((ext_vector_type(4)));
typedef unsigned u32x2 __attribute__((ext_vector_type(2)));

constexpr int DM = 1024, MP = 65536, MS = 2048, M = MP + MS, SEQ = 4096, NIN = 5632, DFF = 2816;
constexpr float EPS = 1e-6f;
constexpr size_t O_Y = 0, O_NKP = (size_t)M * DM, O_NVP = O_NKP + 524288, O_NCP = O_NVP + 524288, O_NKS = O_NCP + 90112, O_NVS = O_NKS + 524288,
                 O_NCS = O_NVS + 524288, O_NGV = O_NCS + 180224, O_END = O_NGV + 2097152;
constexpr size_t MiB = 1u << 20;
constexpr size_t WS_WIN = 1 * MiB, WS_WUP = 12 * MiB, WS_WDN = 23 * MiB, WS_WPA = 29 * MiB, WS_WPB = 31 * MiB, WS_WO = 33 * MiB;
constexpr size_t WS_STATS = 35 * MiB, WS_SS1 = 44 * MiB, WS_HALOA = 49 * MiB, WS_HALOV = 55 * MiB, WS_TAIL = 61 * MiB;
constexpr size_t WS_H = 68 * MiB, WS_U = 200 * MiB, WS_VG = 332 * MiB, WS_Q = 464 * MiB, WS_GA = 596 * MiB, WS_GB = 728 * MiB, WS_K = 860 * MiB, WS_V = 893 * MiB,
                 WS_END = 926 * MiB;
constexpr size_t WS_G = WS_U;
constexpr size_t WS_MG = WS_VG;
constexpr int LDS_BYTES = 147456;
constexpr int RING_BYTES = 131072, BND_OFF = RING_BYTES;

__device__ __forceinline__ unsigned cvt_pk_bf16(float lo, float hi) { unsigned r; asm volatile("v_cvt_pk_bf16_f32 %0, %1, %2" : "=v"(r) : "v"(lo), "v"(hi)); return r; }
__device__ __forceinline__ float bf_lo(unsigned w) { return __builtin_bit_cast(float, w << 16); }
__device__ __forceinline__ float bf_hi(unsigned w) { return __builtin_bit_cast(float, w & 0xffff0000u); }
__device__ __forceinline__ float gelu_t(float x) {
    const float t = __builtin_amdgcn_exp2f(-2.3022081968f * x * (1.0f + 0.044715f * x * x));
    return x * __builtin_amdgcn_rcpf(1.0f + t);
}
__device__ __forceinline__ float sigm(float x) { return __builtin_amdgcn_rcpf(1.0f + __builtin_amdgcn_exp2f(-1.4426950409f * x)); }
__device__ __forceinline__ float wave_sum(float v) {
#pragma unroll
    for (int o = 1; o < 64; o <<= 1) v += __shfl_xor(v, o);
    return v;
}
template <int CTRL> __device__ __forceinline__ float dpp(float v) { return __builtin_bit_cast(float, __builtin_amdgcn_update_dpp(0, __builtin_bit_cast(int, v), CTRL, 0xf, 0xf, false)); }

struct Ptrs {
    const float *xp, *xs, *cache_k, *cache_v, *cache_conv, *ln_mix_g, *w_in, *ln_v_g, *ln_v_b, *w_s, *b_s, *sinks, *w_pa, *w_pb, *w_o, *ln_ffn_g, *w_up, *w_conv, *b_conv,
        *w_down, *ln_final_g;
    float* out;
    bf16_t *WIN, *WUP, *WDN, *WPA, *WPB, *WO, *H, *U, *VG, *Q, *GA, *GB, *KB, *VB, *G, *MG;
    float *STATS, *SS1, *HALOA, *HALOV, *TAIL;
};

namespace pg8 {
constexpr int BM = 256, BK = 64, HALF = 128, HTB = HALF * BK * 2, NXCD = 8, WGM = 8;
__host__ __device__ __forceinline__ int lds_byte(int r, int c) { const int st = (r >> 4) * 2 + (c >> 5), rr = r & 15, cc = c & 31, ob = rr * 64 + cc * 2; return st * 1024 + (ob ^ (((ob >> 9) & 1) << 5)); }
__host__ __device__ __forceinline__ void stage_rc(int b, int& R, int& C) { const int st = b / 1024, sb = b % 1024, swz = sb ^ (((sb >> 9) & 1) << 5); R = (st >> 1) * 16 + swz / 64; C = (st & 1) * 32 + (swz % 64) / 2; }
__host__ __device__ __forceinline__ int perm32(int rho) { const int n = rho >> 4, i = rho & 15; return 8 * (i >> 2) + 4 * n + (i & 3); }

struct Unit { int pm, pn, part; };
struct Gemm {
    const bf16_t *A0, *B0, *A1, *B1; int K;
    __device__ __forceinline__ const char* a_ptr(const Unit& u) const { return (const char*)(u.part ? A1 : A0) + (size_t)u.pm * (size_t)(BM * 2) * K; }
    __device__ __forceinline__ const char* b_ptr(const Unit& u) const { return (const char*)(u.part ? B1 : B0) + (size_t)u.pn * (size_t)(BM * 2) * K; }
};
struct TileOrder {
    int nM, nN, nwg, G, c, parts;
    __device__ void init(int M_, int N_, int G_, int c_, int parts_) { nM = M_ / BM; nN = N_ / BM; nwg = nM * nN; G = G_; c = c_; parts = parts_; }
    __device__ bool next(int i, Unit& u) const {
        const int ti = (parts == 2) ? (i >> 1) : i;
        const long L = (long)ti * G + c; if (L >= nwg) return false;
        int wgid = (int)L; { const int q = nwg / NXCD, r = nwg % NXCD, xcd = wgid % NXCD, off = wgid / NXCD; wgid = (xcd < r ? xcd * (q + 1) : r * (q + 1) + (xcd - r) * q) + off; }
        const int nig = WGM * nN, gid = wgid / nig, fm = gid * WGM, gsz = (nM - fm) < WGM ? (nM - fm) : WGM;
        u.pm = fm + ((wgid % nig) % gsz); u.pn = (wgid % nig) / gsz; u.part = (parts == 2) ? (i & 1) : 0; return true;
    }
};

template <class Epi, class Sched>
__device__ __forceinline__ void gemm_phase(LAS3 unsigned char* lds, const Gemm g, const Sched& S, const Epi& E) {
    const int tid = threadIdx.x, wid = __builtin_amdgcn_readfirstlane(tid >> 6), lane = tid & 63, wr = wid >> 2, wc = wid & 3, fr = lane & 15, fq = lane >> 4;
    const int K = g.K, nt = K / BK;
    unsigned voffA[2], voffB[2];
#pragma unroll
    for (int i = 0; i < 2; ++i) { int R, C; stage_rc(tid * 16 + i * 8192, R, C); const int Rb = (R & ~31) + perm32(R & 31);
        voffA[i] = (unsigned)(R * K + C) * 2u; voffB[i] = (unsigned)(Rb * K + C) * 2u; }
    const size_t kstep = (size_t)(BK * 2);
    const size_t hstep = (size_t)HALF * K * 2;
    const unsigned ldsw = (unsigned)wid * 1024u;
    const int aoff = lds_byte(wr * 64 + fr, fq * 8), boff = lds_byte(wc * 32 + fr, fq * 8);
#define PG8_SA(b, h) (((b) * 2 + (h)) * HTB)
#define PG8_SB(b, h) ((4 + (b) * 2 + (h)) * HTB)
#define PG8_STAGE(bufoff, gbase, voff) do { _Pragma("unroll") for (int _i = 0; _i < 2; ++_i) \
        __builtin_amdgcn_global_load_lds((const unsigned*)((const char*)(gbase) + (voff)[_i]), (LAS3 unsigned*)(lds + (bufoff) + ldsw + _i * 8192), 16, 0, 0); } while (0)
#define PG8_LDA(dst, b, h) do { _Pragma("unroll") for (int m = 0; m < 4; ++m) _Pragma("unroll") for (int k = 0; k < 2; ++k) dst[m][k] = *(const LAS3 bf16x8*)(lds + PG8_SA(b, h) + aoff + m * 2048 + k * 1024); } while (0)
#define PG8_LDB(dst, b, h) do { _Pragma("unroll") for (int n = 0; n < 2; ++n) _Pragma("unroll") for (int k = 0; k < 2; ++k) dst[n][k] = *(const LAS3 bf16x8*)(lds + PG8_SB(b, h) + boff + n * 2048 + k * 1024); } while (0)
#define PG8_MMA(ai, bj, At, Bt) do { __builtin_amdgcn_s_setprio(1); _Pragma("unroll") for (int m = 0; m < 4; ++m) _Pragma("unroll") for (int n = 0; n < 2; ++n) _Pragma("unroll") for (int k = 0; k < 2; ++k) \
        acc[ai][bj][m][n] = __builtin_amdgcn_mfma_f32_16x16x32_bf16(Bt[n][k], At[m][k], acc[ai][bj][m][n], 0, 0, 0); __builtin_amdgcn_s_setprio(0); } while (0)
#define PG8_WAIT_V(n) asm volatile("s_waitcnt vmcnt(" #n ")" ::: "memory")
#define PG8_WAIT_L(n) asm volatile("s_waitcnt lgkmcnt(" #n ")" ::: "memory")
#define PG8_BAR __builtin_amdgcn_s_barrier()
#define PG8_SCHED __builtin_amdgcn_sched_barrier(0)
    Unit cur, nxt; int ui = 0;
    if (!S.next(0, cur)) return;
    f32x4 acc[2][2][4][2];
#pragma unroll
    for (int a = 0; a < 2; ++a)
#pragma unroll
        for (int b = 0; b < 2; ++b)
#pragma unroll
            for (int m = 0; m < 4; ++m)
#pragma unroll
                for (int n = 0; n < 2; ++n) acc[a][b][m][n] = (f32x4){0.f, 0.f, 0.f, 0.f};
    bf16x8 At[4][2], B0[2][2], B1[2][2];
    const char* cA = g.a_ptr(cur); const char* cB = g.b_ptr(cur);
    PG8_STAGE(PG8_SB(0, 0), cB, voffB); PG8_STAGE(PG8_SB(0, 1), cB + hstep, voffB); PG8_STAGE(PG8_SA(0, 0), cA, voffA); PG8_STAGE(PG8_SA(0, 1), cA + hstep, voffA);
    if (wr == 1) PG8_BAR;
    PG8_WAIT_V(2); PG8_BAR;
    PG8_STAGE(PG8_SB(1, 0), cB + kstep, voffB); PG8_STAGE(PG8_SA(1, 0), cA + kstep, voffA); PG8_STAGE(PG8_SB(1, 1), cB + hstep + kstep, voffB);
    PG8_WAIT_V(6); PG8_BAR;
    for (;;) {
        const bool has_next = S.next(ui + 1, nxt);
        const char* nA = has_next ? g.a_ptr(nxt) : cA; const char* nB = has_next ? g.b_ptr(nxt) : cB;
        for (int t = 0; t < nt; t += 2) {
            const bool last = (t == nt - 2);
            const char* a1 = cA + (size_t)(t + 1) * kstep;
            const char* a2 = last ? nA : cA + (size_t)(t + 2) * kstep; const char* b2 = last ? nB : cB + (size_t)(t + 2) * kstep;
            const char* a3 = a2 + kstep; const char* b3 = b2 + kstep;
            PG8_LDB(B0, 0, 0); PG8_LDB(B1, 0, 1); PG8_SCHED; PG8_LDA(At, 0, 0); PG8_STAGE(PG8_SA(1, 1), a1 + hstep, voffA);
            PG8_WAIT_V(8); PG8_WAIT_L(0); PG8_BAR; PG8_MMA(0, 0, At, B0); PG8_MMA(0, 1, At, B1); PG8_BAR; PG8_SCHED;
            PG8_LDA(At, 0, 1); PG8_STAGE(PG8_SB(0, 0), b2, voffB); PG8_STAGE(PG8_SB(0, 1), b2 + hstep, voffB); PG8_STAGE(PG8_SA(0, 0), a2, voffA);
            PG8_WAIT_V(8); PG8_WAIT_L(0); PG8_BAR; PG8_MMA(1, 0, At, B0); PG8_MMA(1, 1, At, B1); PG8_BAR; PG8_SCHED;
            PG8_LDB(B0, 1, 0); PG8_LDB(B1, 1, 1); PG8_SCHED; PG8_LDA(At, 1, 0); PG8_STAGE(PG8_SA(0, 1), a2 + hstep, voffA);
            PG8_WAIT_V(8); PG8_WAIT_L(0); PG8_BAR; PG8_MMA(0, 0, At, B0); PG8_MMA(0, 1, At, B1); PG8_BAR; PG8_SCHED;
            PG8_LDA(At, 1, 1); PG8_STAGE(PG8_SB(1, 0), b3, voffB); PG8_STAGE(PG8_SB(1, 1), b3 + hstep, voffB); PG8_STAGE(PG8_SA(1, 0), a3, voffA);
            PG8_WAIT_V(8); PG8_WAIT_L(0); PG8_BAR; PG8_MMA(1, 0, At, B0); PG8_MMA(1, 1, At, B1); PG8_BAR; PG8_SCHED;
        }
        if (wr == 0) PG8_BAR;
        E(acc, cur, wr, wc, fr, fq, lds);
        if (!has_next) break;
        if (!E.keep(cur)) {
#pragma unroll
            for (int a = 0; a < 2; ++a)
#pragma unroll
                for (int b = 0; b < 2; ++b)
#pragma unroll
                    for (int m = 0; m < 4; ++m)
#pragma unroll
                        for (int n = 0; n < 2; ++n) acc[a][b][m][n] = (f32x4){0.f, 0.f, 0.f, 0.f};
        }
        cur = nxt; cA = nA; cB = nB; ++ui;
        if (wr == 1) PG8_BAR;
    }
    PG8_WAIT_V(0);
    PG8_BAR;
#undef PG8_SA
#undef PG8_SB
#undef PG8_STAGE
#undef PG8_LDA
#undef PG8_LDB
#undef PG8_MMA
#undef PG8_WAIT_V
#undef PG8_WAIT_L
#undef PG8_BAR
#undef PG8_SCHED
}

typedef f32x4 Acc[2][2][4][2];

struct Epi1 {
    Ptrs P;
    __device__ __forceinline__ bool keep(const Unit&) const { return false; }
    __device__ __forceinline__ void operator()(const Acc& acc, const Unit& u, int wr, int wc, int fr, int fq, LAS3 unsigned char*) const {
        asm volatile("" : "+v"(fr), "+v"(fq));
        const int pn = u.pn;
        int act, ld = DM, colt, sidx = -1; bf16_t* base;
        if (pn < 4) { act = 1; base = P.U; colt = pn * BM; }
        else if (pn < 8) { act = 1; base = P.VG; colt = (pn - 4) * BM; sidx = (pn - 4) * 4 + wc; }
        else if (pn < 12) { act = 3; base = P.Q; colt = (pn - 8) * BM; }
        else if (pn < 14) { act = 0; base = pn == 12 ? P.KB : P.VB; colt = 0; ld = 256; }
        else if (pn < 18) { act = 2; base = P.GA; colt = (pn - 14) * BM; }
        else { act = 2; base = P.GB; colt = (pn - 18) * BM; }
        const int row0 = u.pm * BM + wr * 64 + fr, col0 = colt + wc * 32 + 8 * fq;
#pragma unroll
        for (int ai = 0; ai < 2; ++ai)
#pragma unroll
            for (int m = 0; m < 4; ++m) { bf16_t* rowp = base + (size_t)(row0 + ai * HALF + m * 16) * ld + col0; float s = 0.f, q = 0.f;
#pragma unroll
                for (int bj = 0; bj < 2; ++bj) { f32x4 v0 = acc[ai][bj][m][0], v1 = acc[ai][bj][m][1];
                    if (act == 1) {
#pragma unroll
                        for (int j = 0; j < 4; ++j) { v0[j] = gelu_t(v0[j]); v1[j] = gelu_t(v1[j]); } }
                    else if (act == 2) {
#pragma unroll
                        for (int j = 0; j < 4; ++j) { v0[j] = sigm(v0[j]); v1[j] = sigm(v1[j]); } }
                    else if (act == 3) { v0 = v0 * 0.125f; v1 = v1 * 0.125f; }
#pragma unroll
                    for (int j = 0; j < 4; ++j) { s += v0[j] + v1[j]; q += v0[j] * v0[j] + v1[j] * v1[j]; }
                    u32x4 w; w.x = cvt_pk_bf16(v0[0], v0[1]); w.y = cvt_pk_bf16(v0[2], v0[3]); w.z = cvt_pk_bf16(v1[0], v1[1]); w.w = cvt_pk_bf16(v1[2], v1[3]);
                    *(u32x4*)(rowp + bj * HALF) = w; }
                if (sidx >= 0) { s += __shfl_xor(s, 16); s += __shfl_xor(s, 32); q += __shfl_xor(q, 16); q += __shfl_xor(q, 32);
                    if (fq == 0) { float* sp = P.STATS + ((size_t)(row0 + ai * HALF + m * 16) * 16 + sidx) * 2; sp[0] = s; sp[1] = q; } }
                asm volatile("" ::: "memory"); }
        if (pn == 12 || pn == 13) {
            const bool smp = u.pm >= 256; const int j16 = u.pm & 15;
            if (smp || j16 == 15) {
                float* ob = P.out + (smp ? (pn == 12 ? O_NKS : O_NVS) : (pn == 12 ? O_NKP : O_NVP));
#pragma unroll
                for (int ai = 0; ai < 2; ++ai) { if (!smp && ai == 0) continue;
#pragma unroll
                    for (int m = 0; m < 4; ++m) { const int rl = wr * 64 + m * 16 + fr;
                        const size_t orow = smp ? (size_t)((u.pm - 256) * BM + ai * HALF + rl) : (size_t)((u.pm >> 4) * 128 + rl);
#pragma unroll
                        for (int bj = 0; bj < 2; ++bj)
#pragma unroll
                            for (int n = 0; n < 2; ++n) *(f32x4*)(ob + orow * 256 + bj * HALF + wc * 32 + 8 * fq + 4 * n) = acc[ai][bj][m][n];
                        asm volatile("" ::: "memory"); } }
            }
        }
    }
};

struct Epi3 {
    Ptrs P;
    __device__ __forceinline__ bool keep(const Unit& u) const { return u.part == 0; }
    __device__ __forceinline__ void operator()(Acc& acc, const Unit& u, int wr, int wc, int fr, int fq, LAS3 unsigned char*) const {
        asm volatile("" : "+v"(fr), "+v"(fq));
        const int row0 = u.pm * BM + wr * 64 + fr, col0 = u.pn * BM + wc * 32 + 8 * fq;
#pragma unroll
        for (int ai = 0; ai < 2; ++ai)
#pragma unroll
            for (int m = 0; m < 4; ++m) { const size_t off = (size_t)(row0 + ai * HALF + m * 16) * DM + col0;
#pragma unroll
                for (int bj = 0; bj < 2; ++bj) {
                    const u32x4 gb = *(const u32x4*)(P.GB + off + bj * HALF);
                    float b[8] = {bf_lo(gb.x), bf_hi(gb.x), bf_lo(gb.y), bf_hi(gb.y), bf_lo(gb.z), bf_hi(gb.z), bf_lo(gb.w), bf_hi(gb.w)};
#pragma unroll
                    for (int e = 0; e < 8; ++e) b[e] = fmaxf(b[e], 1e-30f);
                    if (u.part == 0) {
                        const u32x4 ga = *(const u32x4*)(P.GA + off + bj * HALF);
                        const float a[8] = {bf_lo(ga.x), bf_hi(ga.x), bf_lo(ga.y), bf_hi(ga.y), bf_lo(ga.z), bf_hi(ga.z), bf_lo(ga.w), bf_hi(ga.w)};
#pragma unroll
                        for (int e = 0; e < 8; ++e) acc[ai][bj][m][e >> 2][e & 3] *= a[e] / b[e];
                    } else {
                        float v[8];
#pragma unroll
                        for (int e = 0; e < 8; ++e) v[e] = acc[ai][bj][m][e >> 2][e & 3] * b[e];
                        u32x4 w; w.x = cvt_pk_bf16(v[0], v[1]); w.y = cvt_pk_bf16(v[2], v[3]); w.z = cvt_pk_bf16(v[4], v[5]); w.w = cvt_pk_bf16(v[6], v[7]);
                        *(u32x4*)(P.MG + off + bj * HALF) = w;
                    } } }
    }
};

struct Epi4 {
    Ptrs P;
    __device__ __forceinline__ bool keep(const Unit&) const { return false; }
    __device__ __forceinline__ void operator()(Acc& acc, const Unit& u, int wr, int wc, int fr, int fq, LAS3 unsigned char*) const {
        asm volatile("" : "+v"(fr), "+v"(fq));
        const int row0 = u.pm * BM + wr * 64 + fr, col0 = u.pn * BM + wc * 32 + 8 * fq;
        const float* xb = u.pm < 256 ? P.xp : P.xs - (size_t)MP * DM;
#pragma unroll
        for (int ai = 0; ai < 2; ++ai)
#pragma unroll
            for (int m = 0; m < 4; ++m) { const int row = row0 + ai * HALF + m * 16; const size_t off = (size_t)row * DM + col0; float q = 0.f;
#pragma unroll
                for (int bj = 0; bj < 2; ++bj) {
                    f32x4 v0 = *(const f32x4*)(xb + off + bj * HALF) + acc[ai][bj][m][0], v1 = *(const f32x4*)(xb + off + bj * HALF + 4) + acc[ai][bj][m][1];
                    *(f32x4*)(P.out + off + bj * HALF) = v0; *(f32x4*)(P.out + off + bj * HALF + 4) = v1;
                    q += (v0[0] * v0[0] + v0[1] * v0[1]) + (v0[2] * v0[2] + v0[3] * v0[3]) + (v1[0] * v1[0] + v1[1] * v1[1]) + (v1[2] * v1[2] + v1[3] * v1[3]);
                    u32x4 w; w.x = cvt_pk_bf16(v0[0], v0[1]); w.y = cvt_pk_bf16(v0[2], v0[3]); w.z = cvt_pk_bf16(v1[0], v1[1]); w.w = cvt_pk_bf16(v1[2], v1[3]);
                    *(u32x4*)(P.H + off + bj * HALF) = w; }
                q += __shfl_xor(q, 16); q += __shfl_xor(q, 32);
                if (fq == 0) P.SS1[(size_t)row * 16 + u.pn * 4 + wc] = q; }
    }
};

struct Epi5 {
    Ptrs P;
    __device__ __forceinline__ bool keep(const Unit&) const { return false; }
    __device__ __forceinline__ void operator()(const Acc& acc, const Unit& u, int wr, int wc, int fr, int fq, LAS3 unsigned char* lds) const {
        asm volatile("" : "+v"(fr), "+v"(fq));
        const int cc = wc * 32 + 8 * fq, col = u.pn * 128 + cc;
        const bool smp = u.pm >= 256; const int j16 = u.pm & 15;
        LAS3 float* bnd = (LAS3 float*)(lds + BND_OFF);
        LAS3 float* rsb = (LAS3 float*)(lds + BND_OFF + 4096) + 8;
        LAS3 float* cw = (LAS3 float*)(lds + BND_OFF + 5376);
        { const int t = threadIdx.x;
          if (t < 256) { const f32x4* sp = (const f32x4*)(P.SS1 + (size_t)(u.pm * BM + t) * 16); const f32x4 s = (sp[0] + sp[1]) + (sp[2] + sp[3]);
              rsb[t] = 1.0f / sqrtf(((s[0] + s[1]) + (s[2] + s[3])) * (1.0f / DM) + EPS); }
          const int k = t >> 7, c = t & 127; cw[t] = k < 3 ? P.w_conv[k * DFF + u.pn * 128 + c] : P.b_conv[u.pn * 128 + c]; }
        asm volatile("s_waitcnt lgkmcnt(0)" ::: "memory"); __builtin_amdgcn_s_barrier(); asm volatile("" ::: "memory");
        if (fr >= 14) {
#pragma unroll
            for (int ai = 0; ai < 2; ++ai) { const int rb = 2 * ai + wr; const float rsm = rsb[rb * 64 + 48 + fr];
#pragma unroll
                for (int n = 0; n < 2; ++n) { const f32x4 v = acc[ai][0][3][n] * rsm;
                    *(LAS3 f32x4*)(bnd + (rb * 2 + (fr - 14)) * 128 + cc + 4 * n) = v;
                    if (rb == 3) { *(f32x4*)(P.TAIL + ((size_t)u.pm * 2 + (fr - 14)) * DFF + col + 4 * n) = v;
                        if (!smp && j16 == 15) *(f32x4*)(P.out + O_NCP + ((size_t)(u.pm >> 4) * 2 + (fr - 14)) * DFF + col + 4 * n) = v; }
                    if (smp) *(f32x4*)(P.out + O_NCS + ((size_t)((u.pm - 256) * 4 + rb) * 2 + (fr - 14)) * DFF + col + 4 * n) = v; } }
        }
        asm volatile("s_waitcnt lgkmcnt(0)" ::: "memory"); __builtin_amdgcn_s_barrier(); asm volatile("" ::: "memory");
#pragma unroll
        for (int n = 0; n < 2; ++n) {
#pragma unroll
            for (int ai = 0; ai < 2; ++ai) { const int rb = 2 * ai + wr;
#pragma unroll
                for (int m = 0; m < 4; ++m) { const int rl = rb * 64 + m * 16 + fr, row = u.pm * BM + rl; float g4[4];
                    const f32x4 w0 = *(const LAS3 f32x4*)(cw + cc + 4 * n), w1 = *(const LAS3 f32x4*)(cw + 128 + cc + 4 * n), w2 = *(const LAS3 f32x4*)(cw + 256 + cc + 4 * n), bc = *(const LAS3 f32x4*)(cw + 384 + cc + 4 * n);
                    const float rsm = rsb[rl], rs1 = rsb[rl - 1], rs2 = rsb[rl - 2];
                    f32x4 B2 = (f32x4){0.f, 0.f, 0.f, 0.f}, B1 = B2;
                    if (m == 0) {
                        if (smp) { const size_t cb = (size_t)((u.pm - 256) * 4 + rb) * 2 * DFF + col + 4 * n; B2 = *(const f32x4*)(P.cache_conv + cb); B1 = *(const f32x4*)(P.cache_conv + cb + DFF); }
                        else if (rb != 0) { B2 = *(const LAS3 f32x4*)(bnd + ((rb - 1) * 2 + 0) * 128 + cc + 4 * n); B1 = *(const LAS3 f32x4*)(bnd + ((rb - 1) * 2 + 1) * 128 + cc + 4 * n); } }
#pragma unroll
                    for (int j = 0; j < 4; ++j) { const float ar = acc[ai][0][m][n][j], a = ar * rsm;
                        const float d1r = dpp<0x121>(ar), d2r = dpp<0x122>(ar);
                        float p1, p2;
                        if (m == 0) { p1 = (fr == 0) ? B1[j] : d1r * rs1; p2 = (fr == 0) ? B2[j] : ((fr == 1) ? B1[j] : d2r * rs2); }
                        else { const float ap = acc[ai][0][m > 0 ? m - 1 : 0][n][j]; const float d1p = dpp<0x121>(ap), d2p = dpp<0x122>(ap);
                            p1 = ((fr == 0) ? d1p : d1r) * rs1; p2 = ((fr < 2) ? d2p : d2r) * rs2; }
                        const float c = bc[j] + w0[j] * p2 + w1[j] * p1 + w2[j] * a;
                        g4[j] = gelu_t(c) * (acc[ai][1][m][n][j] * rsm); }
                    u32x2 w; w.x = cvt_pk_bf16(g4[0], g4[1]); w.y = cvt_pk_bf16(g4[2], g4[3]);
                    *(u32x2*)(P.G + (size_t)row * DFF + col + 4 * n) = w;
                    if (m == 0 && rb == 0 && fr < 2 && !smp && j16 != 0) {
                        *(f32x4*)(P.HALOA + ((size_t)u.pm * 2 + fr) * DFF + col + 4 * n) = acc[ai][0][0][n] * rsm;
                        *(f32x4*)(P.HALOV + ((size_t)u.pm * 2 + fr) * DFF + col + 4 * n) = acc[ai][1][0][n] * rsm; }
                    asm volatile("" ::: "memory"); __builtin_amdgcn_sched_barrier(0);
                }
            }
        }
    }
};

struct Epi6 {
    Ptrs P;
    __device__ __forceinline__ bool keep(const Unit&) const { return false; }
    __device__ __forceinline__ void operator()(Acc& acc, const Unit& u, int wr, int wc, int fr, int fq, LAS3 unsigned char*) const {
        asm volatile("" : "+v"(fr), "+v"(fq));
        const int row0 = u.pm * BM + wr * 64 + fr, col0 = u.pn * BM + wc * 32 + 8 * fq;
#pragma unroll
        for (int ai = 0; ai < 2; ++ai)
#pragma unroll
            for (int m = 0; m < 4; ++m) { float* yp = P.out + (size_t)(row0 + ai * HALF + m * 16) * DM + col0;
#pragma unroll
                for (int bj = 0; bj < 2; ++bj) { const f32x4 v0 = *(const f32x4*)(yp + bj * HALF) + acc[ai][bj][m][0], v1 = *(const f32x4*)(yp + bj * HALF + 4) + acc[ai][bj][m][1];
                    *(f32x4*)(yp + bj * HALF) = v0; *(f32x4*)(yp + bj * HALF + 4) = v1; } }
    }
};
}

__device__ __forceinline__ void transpose_item(const float* W, int K, int N, bf16_t* WT, LAS3 float* scr, int item, int lane, const float* kscale, int mode) {
    const int nblk = N / 32, kb = item / nblk, nb = item % nblk, k0 = 64 * kb, n0 = 32 * nb;
#pragma unroll 8
    for (int i = 0; i < 32; ++i) { const int kk = 2 * i + (lane >> 5); float w = W[(size_t)(k0 + kk) * N + n0 + (lane & 31)]; if (kscale) w *= kscale[k0 + kk]; scr[kk * 33 + (lane & 31)] = w; }
    asm volatile("s_waitcnt lgkmcnt(0)" ::: "memory");
    int r0 = n0;
    if (mode == 1) { const int hv = n0 >= DFF ? 1 : 0, nn = n0 - hv * DFF; r0 = (nn >> 7) * 256 + hv * 128 + (nn & 127); }
    const int c = lane & 7;
#pragma unroll
    for (int j = 0; j < 4; ++j) { const int n = (lane >> 3) + 8 * j; const LAS3 float* s = scr + (8 * c) * 33 + n;
        u32x4 o; o.x = cvt_pk_bf16(s[0 * 33], s[1 * 33]); o.y = cvt_pk_bf16(s[2 * 33], s[3 * 33]); o.z = cvt_pk_bf16(s[4 * 33], s[5 * 33]); o.w = cvt_pk_bf16(s[6 * 33], s[7 * 33]);
        *(u32x4*)(WT + (size_t)(r0 + n) * K + k0 + 8 * c) = o; }
    asm volatile("s_waitcnt lgkmcnt(0)" ::: "memory");
}

__device__ __forceinline__ void spatial_unit(LAS3 unsigned char* lds, const Ptrs& P, int su, int& g_loaded) {
    const int tid = threadIdx.x, wid = __builtin_amdgcn_readfirstlane(tid >> 6), lane = tid & 63, fr = lane & 15, fq = lane >> 4;
    const int g = su & 7, ck = su >> 3; const bool smp = ck >= 512;
    const int nrows = smp ? 64 : 128, row0 = smp ? MP + (ck - 512) * 64 : ck * 128;
    LAS3 unsigned char* WsB = lds;
    LAS3 unsigned char* VnT = lds + 34816;
    if (g != g_loaded) {
#pragma unroll
        for (int i = 0; i < 8; ++i) { const int e = tid + 512 * i, t = e >> 5, s4 = (e & 31) * 4;
            f32x4 w = *(const f32x4*)(P.w_s + ((size_t)g * 128 + t) * 128 + s4);
            if (t < 64 && s4 >= 64) w = (f32x4){0.f, 0.f, 0.f, 0.f};
            u32x2 o; o.x = cvt_pk_bf16(w[0], w[1]); o.y = cvt_pk_bf16(w[2], w[3]);
            *(LAS3 u32x2*)(WsB + t * 272 + s4 * 2) = o; }
        g_loaded = g;
    }
    { const int srow = tid >> 2, c0 = (tid & 3) * 32;
      if (srow < nrows) { const int row = row0 + srow;
        const f32x4* sp = (const f32x4*)(P.STATS + (size_t)row * 32); float s = 0.f, q = 0.f;
#pragma unroll
        for (int i = 0; i < 8; ++i) { const f32x4 v = sp[i]; s += v[0] + v[2]; q += v[1] + v[3]; }
        const float mean = s * (1.0f / DM), var = fmaxf(q * (1.0f / DM) - mean * mean, 0.f), rstd = 1.0f / sqrtf(var + EPS);
#pragma unroll
        for (int i = 0; i < 4; ++i) { const int c = c0 + 8 * i; const u32x4 gv = *(const u32x4*)(P.VG + (size_t)row * DM + g * 128 + c);
            const float x[8] = {bf_lo(gv.x), bf_hi(gv.x), bf_lo(gv.y), bf_hi(gv.y), bf_lo(gv.z), bf_hi(gv.z), bf_lo(gv.w), bf_hi(gv.w)};
            const f32x4 lg0 = *(const f32x4*)(P.ln_v_g + g * 128 + c), lg1 = *(const f32x4*)(P.ln_v_g + g * 128 + c + 4), lb0 = *(const f32x4*)(P.ln_v_b + g * 128 + c), lb1 = *(const f32x4*)(P.ln_v_b + g * 128 + c + 4);
            float vn[8];
#pragma unroll
            for (int e = 0; e < 8; ++e) vn[e] = (x[e] - mean) * rstd * (e < 4 ? lg0[e & 3] : lg1[e & 3]) + (e < 4 ? lb0[e & 3] : lb1[e & 3]);
            if (smp) { float* o = P.out + O_NGV + (size_t)(row - MP) * DM + g * 128 + c; *(f32x4*)o = (f32x4){vn[0], vn[1], vn[2], vn[3]}; *(f32x4*)(o + 4) = (f32x4){vn[4], vn[5], vn[6], vn[7]}; }
#pragma unroll
            for (int e = 0; e < 8; e += 2) { const unsigned w = cvt_pk_bf16(vn[e], vn[e + 1]);
                *(LAS3 unsigned short*)(VnT + (c + e) * 272 + srow * 2) = (unsigned short)(w & 0xffffu); *(LAS3 unsigned short*)(VnT + (c + e + 1) * 272 + srow * 2) = (unsigned short)(w >> 16); } }
      } }
    __syncthreads();
    if (wid * 16 < nrows) {
        f32x4 acc[8];
#pragma unroll
        for (int nb = 0; nb < 8; ++nb) acc[nb] = (f32x4){0.f, 0.f, 0.f, 0.f};
        const int nks = wid < 4 ? 2 : 4;
        for (int ks = 0; ks < nks; ++ks) { const bf16x8 af = *(const LAS3 bf16x8*)(WsB + (wid * 16 + fr) * 272 + (32 * ks + 8 * fq) * 2);
#pragma unroll
            for (int nb = 0; nb < 8; ++nb) { const int c = 32 * (nb >> 1) + 8 * (fr >> 2) + 4 * (nb & 1) + (fr & 3);
                const bf16x8 bfv = *(const LAS3 bf16x8*)(VnT + c * 272 + (32 * ks + 8 * fq) * 2);
                acc[nb] = __builtin_amdgcn_mfma_f32_16x16x32_bf16(bfv, af, acc[nb], 0, 0, 0); } }
        const int t = wid * 16 + fr, row = row0 + t; const float bs = P.b_s[g * 128 + t];
#pragma unroll
        for (int p = 0; p < 4; ++p) { bf16_t* up = P.U + (size_t)row * DM + g * 128 + 32 * p + 8 * fq; const u32x4 uv = *(const u32x4*)up;
            const float x[8] = {bf_lo(uv.x), bf_hi(uv.x), bf_lo(uv.y), bf_hi(uv.y), bf_lo(uv.z), bf_hi(uv.z), bf_lo(uv.w), bf_hi(uv.w)}; float o[8];
#pragma unroll
            for (int e = 0; e < 8; ++e) o[e] = x[e] * (acc[2 * p + (e >> 2)][e & 3] + bs);
            u32x4 w; w.x = cvt_pk_bf16(o[0], o[1]); w.y = cvt_pk_bf16(o[2], o[3]); w.z = cvt_pk_bf16(o[4], o[5]); w.w = cvt_pk_bf16(o[6], o[7]);
            *(u32x4*)up = w; }
    }
    __syncthreads();
}

__device__ __forceinline__ void attn_unit(LAS3 unsigned char* lds, const Ptrs& P, int au) {
    const int tid = threadIdx.x, wid = __builtin_amdgcn_readfirstlane(tid >> 6), lane = tid & 63, l31 = lane & 31, hi = lane >> 5;
    const int hk = au & 3, ch = au >> 2; const bool smp = ch >= 1024;
    const int qrow0 = ch * 64, kmin = smp ? 0 : max(0, 128 - 64 * (ch & 63));
    LAS3 unsigned char* Ks = lds;
    LAS3 unsigned char* VT = lds + 27648;
#pragma unroll
    for (int i = 0; i < 3; ++i) { const int e = tid + 512 * i, kj = e >> 3, part = e & 7;
        u32x4 kv = (u32x4){0u, 0u, 0u, 0u}, vv = kv;
        if (smp && kj < 128) { const size_t o = (((size_t)(ch - 1024) * 128 + kj) * 4 + hk) * 64 + part * 8;
            const f32x4 k0 = *(const f32x4*)(P.cache_k + o), k1 = *(const f32x4*)(P.cache_k + o + 4), v0 = *(const f32x4*)(P.cache_v + o), v1 = *(const f32x4*)(P.cache_v + o + 4);
            kv.x = cvt_pk_bf16(k0[0], k0[1]); kv.y = cvt_pk_bf16(k0[2], k0[3]); kv.z = cvt_pk_bf16(k1[0], k1[1]); kv.w = cvt_pk_bf16(k1[2], k1[3]);
            vv.x = cvt_pk_bf16(v0[0], v0[1]); vv.y = cvt_pk_bf16(v0[2], v0[3]); vv.z = cvt_pk_bf16(v1[0], v1[1]); vv.w = cvt_pk_bf16(v1[2], v1[3]); }
        else if (kj >= kmin) { const size_t o = (size_t)(qrow0 - 128 + kj) * 256 + hk * 64 + part * 8; kv = *(const u32x4*)(P.KB + o); vv = *(const u32x4*)(P.VB + o); }
        *(LAS3 u32x4*)(Ks + kj * 144 + part * 16) = kv;
        const unsigned vw[4] = {vv.x, vv.y, vv.z, vv.w};
#pragma unroll
        for (int x = 0; x < 4; ++x) { *(LAS3 unsigned short*)(VT + (part * 8 + 2 * x) * 400 + kj * 2) = (unsigned short)(vw[x] & 0xffffu); *(LAS3 unsigned short*)(VT + (part * 8 + 2 * x + 1) * 400 + kj * 2) = (unsigned short)(vw[x] >> 16); } }
    const int h = hk * 4 + (wid >> 1), qi = 32 * (wid & 1) + l31;
    bf16_t* qp = P.Q + (size_t)(qrow0 + qi) * DM + h * 64;
    bf16x8 qf[4];
#pragma unroll
    for (int s = 0; s < 4; ++s) qf[s] = *(const bf16x8*)(qp + 16 * s + 8 * hi);
    const float slope = exp2f(-0.5f * (float)(h + 1)), sink = P.sinks[h];
    __syncthreads();
    f32x16 st[6];
#pragma unroll
    for (int kb = 0; kb < 6; ++kb) { f32x16 a;
#pragma unroll
        for (int r = 0; r < 16; ++r) a[r] = 0.f;
#pragma unroll
        for (int s = 0; s < 4; ++s) { const bf16x8 kf = *(const LAS3 bf16x8*)(Ks + (32 * kb + l31) * 144 + (16 * s + 8 * hi) * 2); a = __builtin_amdgcn_mfma_f32_32x32x16_bf16(kf, qf[s], a, 0, 0, 0); }
        st[kb] = a; }
    float mx = -1e30f;
#pragma unroll
    for (int kb = 0; kb < 6; ++kb)
#pragma unroll
        for (int r = 0; r < 16; ++r) { const int key = 32 * kb + (r & 3) + 8 * (r >> 2) + 4 * hi; const int d = qi + 128 - key; const float dist = (float)(d < 0 ? -d : d);
            float s = st[kb][r] - slope * dist; if (key < kmin) s = -1e30f; st[kb][r] = s; mx = fmaxf(mx, s); }
    mx = fmaxf(mx, __shfl_xor(mx, 32)); mx = fmaxf(mx, sink);
    float sum = 0.f;
#pragma unroll
    for (int kb = 0; kb < 6; ++kb)
#pragma unroll
        for (int r = 0; r < 16; ++r) { const float e = __builtin_amdgcn_exp2f((st[kb][r] - mx) * 1.4426950409f); st[kb][r] = e; sum += e; }
    sum += __shfl_xor(sum, 32);
    const float inv = 1.0f / (sum + __builtin_amdgcn_exp2f((sink - mx) * 1.4426950409f));
    f32x16 o0, o1;
#pragma unroll
    for (int r = 0; r < 16; ++r) { o0[r] = 0.f; o1[r] = 0.f; }
#pragma unroll
    for (int kb = 0; kb < 6; ++kb)
#pragma unroll
        for (int s2 = 0; s2 < 2; ++s2) {
            u32x4 pw; pw.x = cvt_pk_bf16(st[kb][8 * s2 + 0], st[kb][8 * s2 + 1]); pw.y = cvt_pk_bf16(st[kb][8 * s2 + 2], st[kb][8 * s2 + 3]);
            pw.z = cvt_pk_bf16(st[kb][8 * s2 + 4], st[kb][8 * s2 + 5]); pw.w = cvt_pk_bf16(st[kb][8 * s2 + 6], st[kb][8 * s2 + 7]);
            const bf16x8 pf = __builtin_bit_cast(bf16x8, pw);
            const int ko = (32 * kb + 16 * s2 + 4 * hi) * 2;
            { const u32x2 a = *(const LAS3 u32x2*)(VT + l31 * 400 + ko), b = *(const LAS3 u32x2*)(VT + l31 * 400 + ko + 16);
              const bf16x8 vf = __builtin_bit_cast(bf16x8, ((u32x4){a.x, a.y, b.x, b.y})); o0 = __builtin_amdgcn_mfma_f32_32x32x16_bf16(vf, pf, o0, 0, 0, 0); }
            { const u32x2 a = *(const LAS3 u32x2*)(VT + (32 + l31) * 400 + ko), b = *(const LAS3 u32x2*)(VT + (32 + l31) * 400 + ko + 16);
              const bf16x8 vf = __builtin_bit_cast(bf16x8, ((u32x4){a.x, a.y, b.x, b.y})); o1 = __builtin_amdgcn_mfma_f32_32x32x16_bf16(vf, pf, o1, 0, 0, 0); }
        }
#pragma unroll
    for (int rq = 0; rq < 4; ++rq) {
        u32x2 w0; w0.x = cvt_pk_bf16(o0[4 * rq] * inv, o0[4 * rq + 1] * inv); w0.y = cvt_pk_bf16(o0[4 * rq + 2] * inv, o0[4 * rq + 3] * inv);
        u32x2 w1; w1.x = cvt_pk_bf16(o1[4 * rq] * inv, o1[4 * rq + 1] * inv); w1.y = cvt_pk_bf16(o1[4 * rq + 2] * inv, o1[4 * rq + 3] * inv);
        *(u32x2*)(qp + 8 * rq + 4 * hi) = w0; *(u32x2*)(qp + 32 + 8 * rq + 4 * hi) = w1; }
    __syncthreads();
}

struct Args { const float* in[21]; float* out; unsigned char* ws; int ph_lo, ph_hi; };
constexpr int N_PHASES = 9;

__global__ void __launch_bounds__(512, 2) mk_fwd(Args args) {
    extern __shared__ __attribute__((aligned(16))) unsigned char lds_raw[];
    LAS3 unsigned char* lds = (LAS3 unsigned char*)lds_raw;
    const int tid = threadIdx.x, lane = tid & 63, wave = __builtin_amdgcn_readfirstlane(tid >> 6);
    const int G = gridDim.x, bx = blockIdx.x;
    Ptrs P;
    P.xp = args.in[0]; P.xs = args.in[1]; P.cache_k = args.in[2]; P.cache_v = args.in[3]; P.cache_conv = args.in[4]; P.ln_mix_g = args.in[5]; P.w_in = args.in[6]; P.ln_v_g = args.in[7];
    P.ln_v_b = args.in[8]; P.w_s = args.in[9]; P.b_s = args.in[10]; P.sinks = args.in[11]; P.w_pa = args.in[12]; P.w_pb = args.in[13]; P.w_o = args.in[14]; P.ln_ffn_g = args.in[15];
    P.w_up = args.in[16]; P.w_conv = args.in[17]; P.b_conv = args.in[18]; P.w_down = args.in[19]; P.ln_final_g = args.in[20];
    P.out = args.out; unsigned char* ws = args.ws;
    P.WIN = (bf16_t*)(ws + WS_WIN); P.WUP = (bf16_t*)(ws + WS_WUP); P.WDN = (bf16_t*)(ws + WS_WDN); P.WPA = (bf16_t*)(ws + WS_WPA); P.WPB = (bf16_t*)(ws + WS_WPB); P.WO = (bf16_t*)(ws + WS_WO);
    P.H = (bf16_t*)(ws + WS_H); P.U = (bf16_t*)(ws + WS_U); P.VG = (bf16_t*)(ws + WS_VG); P.Q = (bf16_t*)(ws + WS_Q); P.GA = (bf16_t*)(ws + WS_GA); P.GB = (bf16_t*)(ws + WS_GB);
    P.KB = (bf16_t*)(ws + WS_K); P.VB = (bf16_t*)(ws + WS_V); P.G = (bf16_t*)(ws + WS_G); P.MG = (bf16_t*)(ws + WS_MG);
    P.STATS = (float*)(ws + WS_STATS); P.SS1 = (float*)(ws + WS_SS1); P.HALOA = (float*)(ws + WS_HALOA); P.HALOV = (float*)(ws + WS_HALOV); P.TAIL = (float*)(ws + WS_TAIL);
    const int lo = args.ph_lo, hi = args.ph_hi;
#ifndef PH_MASK
#define PH_MASK 0x1ff
#endif
#define IN(k) (((PH_MASK >> (k)) & 1) && lo <= (k) && (k) < hi)
#define SEAM(k) do { if (IN(k) && IN((k) + 1)) cg::this_grid().sync(); } while (0)
    const int gw = bx * 8 + wave, NGW = G * 8;

    if (IN(0)) {
        LAS3 float* scr = (LAS3 float*)(lds + wave * 16384);
        constexpr int I_IN = (DM / 64) * (NIN / 32), I_SQ = (DM / 64) * (DM / 32), I_DN = (DFF / 64) * (DM / 32);
        constexpr int NITEMS = 2 * I_IN + 3 * I_SQ + I_DN;
        for (int it = gw; it < NITEMS; it += NGW) {
            int r = it;
            if (r < I_IN) { transpose_item(P.w_in, DM, NIN, P.WIN, scr, r, lane, nullptr, 0); continue; } r -= I_IN;
            if (r < I_IN) { transpose_item(P.w_up, DM, NIN, P.WUP, scr, r, lane, P.ln_ffn_g, 1); continue; } r -= I_IN;
            if (r < I_SQ) { transpose_item(P.w_pa, DM, DM, P.WPA, scr, r, lane, nullptr, 0); continue; } r -= I_SQ;
            if (r < I_SQ) { transpose_item(P.w_pb, DM, DM, P.WPB, scr, r, lane, nullptr, 0); continue; } r -= I_SQ;
            if (r < I_SQ) { transpose_item(P.w_o, DM, DM, P.WO, scr, r, lane, nullptr, 0); continue; } r -= I_SQ;
            transpose_item(P.w_down, DFF, DM, P.WDN, scr, r, lane, nullptr, 0);
        }
        f32x4 gm[4];
#pragma unroll
        for (int j = 0; j < 4; ++j) gm[j] = ((const f32x4*)P.ln_mix_g)[lane + 64 * j];
        for (int m = gw; m < M; m += NGW) {
            const float* xr = m < MP ? P.xp + (size_t)m * DM : P.xs + (size_t)(m - MP) * DM;
            f32x4 v[4]; float s = 0.f;
#pragma unroll
            for (int j = 0; j < 4; ++j) { v[j] = ((const f32x4*)xr)[lane + 64 * j]; s += (v[j][0] * v[j][0] + v[j][1] * v[j][1]) + (v[j][2] * v[j][2] + v[j][3] * v[j][3]); }
            const float rstd = 1.0f / sqrtf(wave_sum(s) * (1.0f / DM) + EPS);
            u32x2* o8 = (u32x2*)(P.H + (size_t)m * DM) + lane;
#pragma unroll
            for (int j = 0; j < 4; ++j) { u32x2 w; w.x = cvt_pk_bf16(v[j][0] * rstd * gm[j][0], v[j][1] * rstd * gm[j][1]); w.y = cvt_pk_bf16(v[j][2] * rstd * gm[j][2], v[j][3] * rstd * gm[j][3]); o8[64 * j] = w; }
        }
    }
    SEAM(0);
    if (IN(1)) {
        pg8::Gemm g{P.H, P.WIN, P.H, P.WIN, DM}; pg8::TileOrder S; S.init(M, NIN, G, bx, 1); pg8::Epi1 E{P};
        pg8::gemm_phase(lds, g, S, E);
    }
    SEAM(1);
    if (IN(2)) {
        int g_loaded = -1;
        for (int su = bx; su < (512 + 32) * 8; su += G) spatial_unit(lds, P, su, g_loaded);
        for (int au = bx; au < (1024 + 32) * 4; au += G) attn_unit(lds, P, au);
    }
    SEAM(2);
    if (IN(3)) {
        pg8::Gemm g{P.U, P.WPA, P.Q, P.WPB, DM}; pg8::TileOrder S; S.init(M, DM, G, bx, 2); pg8::Epi3 E{P};
        pg8::gemm_phase(lds, g, S, E);
    }
    SEAM(3);
    if (IN(4)) {
        pg8::Gemm g{P.MG, P.WO, P.MG, P.WO, DM}; pg8::TileOrder S; S.init(M, DM, G, bx, 1); pg8::Epi4 E{P};
        pg8::gemm_phase(lds, g, S, E);
    }
    SEAM(4);
    if (IN(5)) {
        pg8::Gemm g{P.H, P.WUP, P.H, P.WUP, DM}; pg8::TileOrder S; S.init(M, NIN, G, bx, 1); pg8::Epi5 E{P};
        pg8::gemm_phase(lds, g, S, E);
    }
    SEAM(5);
    if (IN(6)) {
        const int total = 256 * DFF;
        for (int e = bx * 512 + tid; e < total; e += G * 512) { const int pm = e / DFF, col = e - pm * DFF; if ((pm & 15) == 0) continue;
            const float a0 = P.HALOA[((size_t)pm * 2) * DFF + col], a1 = P.HALOA[((size_t)pm * 2 + 1) * DFF + col], v0 = P.HALOV[((size_t)pm * 2) * DFF + col], v1 = P.HALOV[((size_t)pm * 2 + 1) * DFF + col];
            const float p2 = P.TAIL[((size_t)(pm - 1) * 2) * DFF + col], p1 = P.TAIL[((size_t)(pm - 1) * 2 + 1) * DFF + col];
            const float w0 = P.w_conv[col], w1 = P.w_conv[DFF + col], w2 = P.w_conv[2 * DFF + col], bc = P.b_conv[col];
            const float c0 = bc + w0 * p2 + w1 * p1 + w2 * a0, c1 = bc + w0 * p1 + w1 * a0 + w2 * a1;
            const unsigned w = cvt_pk_bf16(gelu_t(c0) * v0, gelu_t(c1) * v1);
            P.G[(size_t)(pm * 256) * DFF + col] = (bf16_t)(w & 0xffffu); P.G[(size_t)(pm * 256 + 1) * DFF + col] = (bf16_t)(w >> 16); }
    }
    SEAM(6);
    if (IN(7)) {
        pg8::Gemm g{P.G, P.WDN, P.G, P.WDN, DFF}; pg8::TileOrder S; S.init(M, DM, G, bx, 1); pg8::Epi6 E{P};
        pg8::gemm_phase(lds, g, S, E);
    }
    SEAM(7);
    if (IN(8)) {
        f32x4 gm[4];
#pragma unroll
        for (int j = 0; j < 4; ++j) gm[j] = ((const f32x4*)P.ln_final_g)[lane + 64 * j];
        for (int m = gw; m < M; m += NGW) {
            f32x4* yr = (f32x4*)(P.out + (size_t)m * DM) + lane;
            f32x4 v[4]; float s = 0.f;
#pragma unroll
            for (int j = 0; j < 4; ++j) { v[j] = yr[64 * j]; s += (v[j][0] * v[j][0] + v[j][1] * v[j][1]) + (v[j][2] * v[j][2] + v[j][3] * v[j][3]); }
            const float rstd = 1.0f / sqrtf(wave_sum(s) * (1.0f / DM) + EPS);
#pragma unroll
            for (int j = 0; j < 4; ++j) yr[64 * j] = v[j] * rstd * gm[j];
        }
    }
#undef IN
#undef SEAM
}

extern "C" void kernel_launch(void* const* d_in, const int* in_sizes, int n_in, void* d_out, int out_size, void* d_ws, size_t ws_size, hipStream_t stream) {
    static int grid = 0;
    if (grid == 0) {
        if (n_in != 21 || in_sizes[0] != MP * DM || (size_t)out_size != O_END || ws_size < WS_END) {
            fprintf(stderr, "kernel_launch: shape mismatch: n_in %d in0 %d out %d ws %zu (need %zu)\n", n_in, n_in > 0 ? in_sizes[0] : -1, out_size, ws_size, (size_t)WS_END); grid = -1; return; }
        int dev = 0, cus = 0, per_cu = 0;
        (void)hipGetDevice(&dev); (void)hipDeviceGetAttribute(&cus, hipDeviceAttributeMultiprocessorCount, dev);
        if (hipFuncSetAttribute((const void*)mk_fwd, hipFuncAttributeMaxDynamicSharedMemorySize, LDS_BYTES) != hipSuccess) { fprintf(stderr, "kernel_launch: hipFuncSetAttribute failed\n"); grid = -1; return; }
        if (hipOccupancyMaxActiveBlocksPerMultiprocessor(&per_cu, (const void*)mk_fwd, 512, LDS_BYTES) != hipSuccess || per_cu < 1) { fprintf(stderr, "kernel_launch: occupancy query says %d\n", per_cu); per_cu = 1; }
        (void)hipGetLastError();
        grid = cus * 1;
        fprintf(stderr, "kernel_launch: cus %d per_cu %d grid %d\n", cus, per_cu, grid);
    }
    if (grid < 0) return;
    Args a{};
    for (int i = 0; i < 21; ++i) a.in[i] = (const float*)d_in[i];
    a.out = (float*)d_out; a.ws = (unsigned char*)d_ws;
#if MK_ONE_LAUNCH
    a.ph_lo = 0; a.ph_hi = N_PHASES;
    void* kargs[] = {&a};
    hipError_t e = hipLaunchCooperativeKernel((const void*)mk_fwd, dim3(grid), dim3(512), kargs, LDS_BYTES, stream);
    if (e != hipSuccess) fprintf(stderr, "kernel_launch: cooperative launch failed: %s (grid %d)\n", hipGetErrorString(e), grid);
#else
    for (int k = 0; k < N_PHASES; ++k) { a.ph_lo = k; a.ph_hi = k + 1; hipLaunchKernelGGL(mk_fwd, dim3(grid), dim3(512), LDS_BYTES, stream, a); }
#endif
}
```

```cpp
#include <hip/hip_runtime.h>
#include <hip/hip_cooperative_groups.h>
#include <cstdio>
#include <cstdint>
namespace cg = cooperative_groups;

#ifndef MK_ONE_LAUNCH
#define MK_ONE_LAUNCH 1
#endif

#define LAS3 __attribute__((address_space(3)))
typedef unsigned short bf16_t;
typedef short bf16x8 __attribute__((ext_vector_type(8)));
typedef short s16x4 __attribute__((ext_vector_type(4)));
typedef float f32x4 __attribute__((ext_vector_type(4)));
typedef float f32x16 __attribute__((ext_vector_type(16)));
typedef unsigned u32x4 __attribute__((ext_vector_type(4)));
typedef unsigned u32x2 __attribute__((ext_vector_type(2)));

constexpr int DM = 1024, MP = 65536, MS = 2048, M = MP + MS, SEQ = 4096, NIN = 5632, DFF = 2816;
constexpr float EPS = 1e-6f;
constexpr size_t O_Y = 0, O_NKP = (size_t)M * DM, O_NVP = O_NKP + 524288, O_NCP = O_NVP + 524288, O_NKS = O_NCP + 90112, O_NVS = O_NKS + 524288,
                 O_NCS = O_NVS + 524288, O_NGV = O_NCS + 180224, O_END = O_NGV + 2097152;
constexpr size_t MiB = 1u << 20;
constexpr size_t WS_WIN = 1 * MiB, WS_WUP = 12 * MiB, WS_WDN = 23 * MiB, WS_WPA = 29 * MiB, WS_WPB = 31 * MiB, WS_WO = 33 * MiB;
constexpr size_t WS_STATS = 35 * MiB, WS_SS1 = 44 * MiB, WS_HALOA = 49 * MiB, WS_HALOV = 55 * MiB, WS_TAIL = 61 * MiB;
constexpr size_t WS_H = 68 * MiB, WS_U = 200 * MiB, WS_VG = 332 * MiB, WS_Q = 464 * MiB, WS_GA = 596 * MiB, WS_GB = 728 * MiB, WS_K = 860 * MiB, WS_V = 893 * MiB,
                 WS_END = 926 * MiB;
constexpr size_t WS_G = WS_U;
constexpr size_t WS_MG = WS_VG;
constexpr int LDS_BYTES = 147456;
constexpr int RING_BYTES = 131072, BND_OFF = RING_BYTES;

__device__ __forceinline__ unsigned cvt_pk_bf16(float lo, float hi) { unsigned r; asm volatile("v_cvt_pk_bf16_f32 %0, %1, %2" : "=v"(r) : "v"(lo), "v"(hi)); return r; }
__device__ __forceinline__ float bf_lo(unsigned w) { return __builtin_bit_cast(float, w << 16); }
__device__ __forceinline__ float bf_hi(unsigned w) { return __builtin_bit_cast(float, w & 0xffff0000u); }
__device__ __forceinline__ float gelu_t(float x) {
    const float t = __builtin_amdgcn_exp2f(-2.3022081968f * x * (1.0f + 0.044715f * x * x));
    return x * __builtin_amdgcn_rcpf(1.0f + t);
}
__device__ __forceinline__ float sigm(float x) { return __builtin_amdgcn_rcpf(1.0f + __builtin_amdgcn_exp2f(-1.4426950409f * x)); }
__device__ __forceinline__ float wave_sum(float v) {
#pragma unroll
    for (int o = 1; o < 64; o <<= 1) v += __shfl_xor(v, o);
    return v;
}
template <int CTRL> __device__ __forceinline__ float dpp(float v) { return __builtin_bit_cast(float, __builtin_amdgcn_update_dpp(0, __builtin_bit_cast(int, v), CTRL, 0xf, 0xf, false)); }

struct Ptrs {
    const float *xp, *xs, *cache_k, *cache_v, *cache_conv, *ln_mix_g, *w_in, *ln_v_g, *ln_v_b, *w_s, *b_s, *sinks, *w_pa, *w_pb, *w_o, *ln_ffn_g, *w_up, *w_conv, *b_conv,
        *w_down, *ln_final_g;
    float* out;
    bf16_t *WIN, *WUP, *WDN, *WPA, *WPB, *WO, *H, *U, *VG, *Q, *GA, *GB, *KB, *VB, *G, *MG;
    float *STATS, *SS1, *HALOA, *HALOV, *TAIL;
};

namespace pg8 {
constexpr int BM = 256, BK = 64, HALF = 128, HTB = HALF * BK * 2, NXCD = 8, WGM = 8;
__host__ __device__ __forceinline__ int lds_byte(int r, int c) { const int st = (r >> 4) * 2 + (c >> 5), rr = r & 15, cc = c & 31, ob = rr * 64 + cc * 2; return st * 1024 + (ob ^ (((ob >> 9) & 1) << 5)); }
__host__ __device__ __forceinline__ void stage_rc(int b, int& R, int& C) { const int st = b / 1024, sb = b % 1024, swz = sb ^ (((sb >> 9) & 1) << 5); R = (st >> 1) * 16 + swz / 64; C = (st & 1) * 32 + (swz % 64) / 2; }
__host__ __device__ __forceinline__ int perm32(int rho) { const int n = rho >> 4, i = rho & 15; return 8 * (i >> 2) + 4 * n + (i & 3); }

struct Unit { int pm, pn, part; };
struct Gemm {
    const bf16_t *A0, *B0, *A1, *B1; int K;
    __device__ __forceinline__ const char* a_ptr(const Unit& u) const { return (const char*)(u.part ? A1 : A0) + (size_t)u.pm * (size_t)(BM * 2) * K; }
    __device__ __forceinline__ const char* b_ptr(const Unit& u) const { return (const char*)(u.part ? B1 : B0) + (size_t)u.pn * (size_t)(BM * 2) * K; }
};
struct TileOrder {
    int nM, nN, nwg, G, c, parts;
    __device__ void init(int M_, int N_, int G_, int c_, int parts_) { nM = M_ / BM; nN = N_ / BM; nwg = nM * nN; G = G_; c = c_; parts = parts_; }
    __device__ bool next(int i, Unit& u) const {
        const int ti = (parts == 2) ? (i >> 1) : i;
        const long L = (long)ti * G + c; if (L >= nwg) return false;
        int wgid = (int)L; { const int q = nwg / NXCD, r = nwg % NXCD, xcd = wgid % NXCD, off = wgid / NXCD; wgid = (xcd < r ? xcd * (q + 1) : r * (q + 1) + (xcd - r) * q) + off; }
        const int nig = WGM * nN, gid = wgid / nig, fm = gid * WGM, gsz = (nM - fm) < WGM ? (nM - fm) : WGM;
        u.pm = fm + ((wgid % nig) % gsz); u.pn = (wgid % nig) / gsz; u.part = (parts == 2) ? (i & 1) : 0; return true;
    }
};

template <class Epi, class Sched>
__device__ __forceinline__ void gemm_phase(LAS3 unsigned char* lds, const Gemm g, const Sched& S, const Epi& E) {
    const int tid = threadIdx.x, wid = __builtin_amdgcn_readfirstlane(tid >> 6), lane = tid & 63, wr = wid >> 2, wc = wid & 3, fr = lane & 15, fq = lane >> 4;
    const int K = g.K, nt = K / BK;
    unsigned voffA[2], voffB[2];
#pragma unroll
    for (int i = 0; i < 2; ++i) { int R, C; stage_rc(tid * 16 + i * 8192, R, C); const int Rb = (R & ~31) + perm32(R & 31);
        voffA[i] = (unsigned)(R * K + C) * 2u; voffB[i] = (unsigned)(Rb * K + C) * 2u; }
    const size_t kstep = (size_t)(BK * 2);
    const size_t hstep = (size_t)HALF * K * 2;
    const unsigned ldsw = (unsigned)wid * 1024u;
    const int aoff = lds_byte(wr * 64 + fr, fq * 8), boff = lds_byte(wc * 32 + fr, fq * 8);
#define PG8_SA(b, h) (((b) * 2 + (h)) * HTB)
#define PG8_SB(b, h) ((4 + (b) * 2 + (h)) * HTB)
#define PG8_STAGE(bufoff, gbase, voff) do { _Pragma("unroll") for (int _i = 0; _i < 2; ++_i) \
        __builtin_amdgcn_global_load_lds((const unsigned*)((const char*)(gbase) + (voff)[_i]), (LAS3 unsigned*)(lds + (bufoff) + ldsw + _i * 8192), 16, 0, 0); } while (0)
#define PG8_LDA(dst, b, h) do { _Pragma("unroll") for (int m = 0; m < 4; ++m) _Pragma("unroll") for (int k = 0; k < 2; ++k) dst[m][k] = *(const LAS3 bf16x8*)(lds + PG8_SA(b, h) + aoff + m * 2048 + k * 1024); } while (0)
#define PG8_LDB(dst, b, h) do { _Pragma("unroll") for (int n = 0; n < 2; ++n) _Pragma("unroll") for (int k = 0; k < 2; ++k) dst[n][k] = *(const LAS3 bf16x8*)(lds + PG8_SB(b, h) + boff + n * 2048 + k * 1024); } while (0)
#define PG8_MMA(ai, bj, At, Bt) do { __builtin_amdgcn_s_setprio(1); _Pragma("unroll") for (int m = 0; m < 4; ++m) _Pragma("unroll") for (int n = 0; n < 2; ++n) _Pragma("unroll") for (int k = 0; k < 2; ++k) \
        acc[ai][bj][m][n] = __builtin_amdgcn_mfma_f32_16x16x32_bf16(Bt[n][k], At[m][k], acc[ai][bj][m][n], 0, 0, 0); __builtin_amdgcn_s_setprio(0); } while (0)
#define PG8_WAIT_V(n) asm volatile("s_waitcnt vmcnt(" #n ")" ::: "memory")
#define PG8_WAIT_L(n) asm volatile("s_waitcnt lgkmcnt(" #n ")" ::: "memory")
#define PG8_BAR __builtin_amdgcn_s_barrier()
#define PG8_SCHED __builtin_amdgcn_sched_barrier(0)
    Unit cur, nxt; int ui = 0;
    if (!S.next(0, cur)) return;
    f32x4 acc[2][2][4][2];
#pragma unroll
    for (int a = 0; a < 2; ++a)
#pragma unroll
        for (int b = 0; b < 2; ++b)
#pragma unroll
            for (int m = 0; m < 4; ++m)
#pragma unroll
                for (int n = 0; n < 2; ++n) acc[a][b][m][n] = (f32x4){0.f, 0.f, 0.f, 0.f};
    bf16x8 At[4][2], B0[2][2], B1[2][2];
    const char* cA = g.a_ptr(cur); const char* cB = g.b_ptr(cur);
    PG8_STAGE(PG8_SB(0, 0), cB, voffB); PG8_STAGE(PG8_SB(0, 1), cB + hstep, voffB); PG8_STAGE(PG8_SA(0, 0), cA, voffA); PG8_STAGE(PG8_SA(0, 1), cA + hstep, voffA);
    if (wr == 1) PG8_BAR;
    PG8_WAIT_V(2); PG8_BAR;
    PG8_STAGE(PG8_SB(1, 0), cB + kstep, voffB); PG8_STAGE(PG8_SA(1, 0), cA + kstep, voffA); PG8_STAGE(PG8_SB(1, 1), cB + hstep + kstep, voffB);
    PG8_WAIT_V(6); PG8_BAR;
    for (;;) {
        const bool has_next = S.next(ui + 1, nxt);
        const char* nA = has_next ? g.a_ptr(nxt) : cA; const char* nB = has_next ? g.b_ptr(nxt) : cB;
        for (int t = 0; t < nt; t += 2) {
            const bool last = (t == nt - 2);
            const char* a1 = cA + (size_t)(t + 1) * kstep;
            const char* a2 = last ? nA : cA + (size_t)(t + 2) * kstep; const char* b2 = last ? nB : cB + (size_t)(t + 2) * kstep;
            const char* a3 = a2 + kstep; const char* b3 = b2 + kstep;
            PG8_LDB(B0, 0, 0); PG8_LDB(B1, 0, 1); PG8_SCHED; PG8_LDA(At, 0, 0); PG8_STAGE(PG8_SA(1, 1), a1 + hstep, voffA);
            PG8_WAIT_V(8); PG8_WAIT_L(0); PG8_BAR; PG8_MMA(0, 0, At, B0); PG8_MMA(0, 1, At, B1); PG8_BAR; PG8_SCHED;
            PG8_LDA(At, 0, 1); PG8_STAGE(PG8_SB(0, 0), b2, voffB); PG8_STAGE(PG8_SB(0, 1), b2 + hstep, voffB); PG8_STAGE(PG8_SA(0, 0), a2, voffA);
            PG8_WAIT_V(8); PG8_WAIT_L(0); PG8_BAR; PG8_MMA(1, 0, At, B0); PG8_MMA(1, 1, At, B1); PG8_BAR; PG8_SCHED;
            PG8_LDB(B0, 1, 0); PG8_LDB(B1, 1, 1); PG8_SCHED; PG8_LDA(At, 1, 0); PG8_STAGE(PG8_SA(0, 1), a2 + hstep, voffA);
            PG8_WAIT_V(8); PG8_WAIT_L(0); PG8_BAR; PG8_MMA(0, 0, At, B0); PG8_MMA(0, 1, At, B1); PG8_BAR; PG8_SCHED;
            PG8_LDA(At, 1, 1); PG8_STAGE(PG8_SB(1, 0), b3, voffB); PG8_STAGE(PG8_SB(1, 1), b3 + hstep, voffB); PG8_STAGE(PG8_SA(1, 0), a3, voffA);
            PG8_WAIT_V(8); PG8_WAIT_L(0); PG8_BAR; PG8_MMA(1, 0, At, B0); PG8_MMA(1, 1, At, B1); PG8_BAR; PG8_SCHED;
        }
        if (wr == 0) PG8_BAR;
        E(acc, cur, wr, wc, fr, fq, lds);
        if (!has_next) break;
        if (!E.keep(cur)) {
#pragma unroll
            for (int a = 0; a < 2; ++a)
#pragma unroll
                for (int b = 0; b < 2; ++b)
#pragma unroll
                    for (int m = 0; m < 4; ++m)
#pragma unroll
                        for (int n = 0; n < 2; ++n) acc[a][b][m][n] = (f32x4){0.f, 0.f, 0.f, 0.f};
        }
        cur = nxt; cA = nA; cB = nB; ++ui;
        if (wr == 1) PG8_BAR;
    }
    PG8_WAIT_V(0);
    PG8_BAR;
#undef PG8_SA
#undef PG8_SB
#undef PG8_STAGE
#undef PG8_LDA
#undef PG8_LDB
#undef PG8_MMA
#undef PG8_WAIT_V
#undef PG8_WAIT_L
#undef PG8_BAR
#undef PG8_SCHED
}

typedef f32x4 Acc[2][2][4][2];

struct Epi1 {
    Ptrs P;
    __device__ __forceinline__ bool keep(const Unit&) const { return false; }
    __device__ __forceinline__ void operator()(const Acc& acc, const Unit& u, int wr, int wc, int fr, int fq, LAS3 unsigned char*) const {
        asm volatile("" : "+v"(fr), "+v"(fq));
        const int pn = u.pn;
        int act, ld = DM, colt, sidx = -1; bf16_t* base;
        if (pn < 4) { act = 1; base = P.U; colt = pn * BM; }
        else if (pn < 8) { act = 1; base = P.VG; colt = (pn - 4) * BM; sidx = (pn - 4) * 4 + wc; }
        else if (pn < 12) { act = 3; base = P.Q; colt = (pn - 8) * BM; }
        else if (pn < 14) { act = 0; base = pn == 12 ? P.KB : P.VB; colt = 0; ld = 256; }
        else if (pn < 18) { act = 2; base = P.GA; colt = (pn - 14) * BM; }
        else { act = 2; base = P.GB; colt = (pn - 18) * BM; }
        const int row0 = u.pm * BM + wr * 64 + fr, col0 = colt + wc * 32 + 8 * fq;
#pragma unroll
        for (int ai = 0; ai < 2; ++ai)
#pragma unroll
            for (int m = 0; m < 4; ++m) { bf16_t* rowp = base + (size_t)(row0 + ai * HALF + m * 16) * ld + col0; float s = 0.f, q = 0.f;
#pragma unroll
                for (int bj = 0; bj < 2; ++bj) { f32x4 v0 = acc[ai][bj][m][0], v1 = acc[ai][bj][m][1];
                    if (act == 1) {
#pragma unroll
                        for (int j = 0; j < 4; ++j) { v0[j] = gelu_t(v0[j]); v1[j] = gelu_t(v1[j]); } }
                    else if (act == 2) {
#pragma unroll
                        for (int j = 0; j < 4; ++j) { v0[j] = sigm(v0[j]); v1[j] = sigm(v1[j]); } }
                    else if (act == 3) { v0 = v0 * 0.125f; v1 = v1 * 0.125f; }
#pragma unroll
                    for (int j = 0; j < 4; ++j) { s += v0[j] + v1[j]; q += v0[j] * v0[j] + v1[j] * v1[j]; }
                    u32x4 w; w.x = cvt_pk_bf16(v0[0], v0[1]); w.y = cvt_pk_bf16(v0[2], v0[3]); w.z = cvt_pk_bf16(v1[0], v1[1]); w.w = cvt_pk_bf16(v1[2], v1[3]);
                    *(u32x4*)(rowp + bj * HALF) = w; }
                if (sidx >= 0) { s += __shfl_xor(s, 16); s += __shfl_xor(s, 32); q += __shfl_xor(q, 16); q += __shfl_xor(q, 32);
                    if (fq == 0) { float* sp = P.STATS + ((size_t)(row0 + ai * HALF + m * 16) * 16 + sidx) * 2; sp[0] = s; sp[1] = q; } }
                asm volatile("" ::: "memory"); }
        if (pn == 12 || pn == 13) {
            const bool smp = u.pm >= 256; const int j16 = u.pm & 15;
            if (smp || j16 == 15) {
                float* ob = P.out + (smp ? (pn == 12 ? O_NKS : O_NVS) : (pn == 12 ? O_NKP : O_NVP));
#pragma unroll
                for (int ai = 0; ai < 2; ++ai) { if (!smp && ai == 0) continue;
#pragma unroll
                    for (int m = 0; m < 4; ++m) { const int rl = wr * 64 + m * 16 + fr;
                        const size_t orow = smp ? (size_t)((u.pm - 256) * BM + ai * HALF + rl) : (size_t)((u.pm >> 4) * 128 + rl);
#pragma unroll
                        for (int bj = 0; bj < 2; ++bj)
#pragma unroll
                            for (int n = 0; n < 2; ++n) *(f32x4*)(ob + orow * 256 + bj * HALF + wc * 32 + 8 * fq + 4 * n) = acc[ai][bj][m][n];
                        asm volatile("" ::: "memory"); } }
            }
        }
    }
};

struct Epi3 {
    Ptrs P;
    __device__ __forceinline__ bool keep(const Unit& u) const { return u.part == 0; }
    __device__ __forceinline__ void operator()(Acc& acc, const Unit& u, int wr, int wc, int fr, int fq, LAS3 unsigned char*) const {
        asm volatile("" : "+v"(fr), "+v"(fq));
        const int row0 = u.pm * BM + wr * 64 + fr, col0 = u.pn * BM + wc * 32 + 8 * fq;
#pragma unroll
        for (int ai = 0; ai < 2; ++ai)
#pragma unroll
            for (int m = 0; m < 4; ++m) { const size_t off = (size_t)(row0 + ai * HALF + m * 16) * DM + col0;
#pragma unroll
                for (int bj = 0; bj < 2; ++bj) {
                    const u32x4 gb = *(const u32x4*)(P.GB + off + bj * HALF);
                    float b[8] = {bf_lo(gb.x), bf_hi(gb.x), bf_lo(gb.y), bf_hi(gb.y), bf_lo(gb.z), bf_hi(gb.z), bf_lo(gb.w), bf_hi(gb.w)};
#pragma unroll
                    for (int e = 0; e < 8; ++e) b[e] = fmaxf(b[e], 1e-30f);
                    if (u.part == 0) {
                        const u32x4 ga = *(const u32x4*)(P.GA + off + bj * HALF);
                        const float a[8] = {bf_lo(ga.x), bf_hi(ga.x), bf_lo(ga.y), bf_hi(ga.y), bf_lo(ga.z), bf_hi(ga.z), bf_lo(ga.w), bf_hi(ga.w)};
#pragma unroll
                        for (int e = 0; e < 8; ++e) acc[ai][bj][m][e >> 2][e & 3] *= a[e] / b[e];
                    } else {
                        float v[8];
#pragma unroll
                        for (int e = 0; e < 8; ++e) v[e] = acc[ai][bj][m][e >> 2][e & 3] * b[e];
                        u32x4 w; w.x = cvt_pk_bf16(v[0], v[1]); w.y = cvt_pk_bf16(v[2], v[3]); w.z = cvt_pk_bf16(v[4], v[5]); w.w = cvt_pk_bf16(v[6], v[7]);
                        *(u32x4*)(P.MG + off + bj * HALF) = w;
                    } } }
    }
};

struct Epi4 {
    Ptrs P;
    __device__ __forceinline__ bool keep(const Unit&) const { return false; }
    __device__ __forceinline__ void operator()(Acc& acc, const Unit& u, int wr, int wc, int fr, int fq, LAS3 unsigned char*) const {
        asm volatile("" : "+v"(fr), "+v"(fq));
        const int row0 = u.pm * BM + wr * 64 + fr, col0 = u.pn * BM + wc * 32 + 8 * fq;
        const float* xb = u.pm < 256 ? P.xp : P.xs - (size_t)MP * DM;
#pragma unroll
        for (int ai = 0; ai < 2; ++ai)
#pragma unroll
            for (int m = 0; m < 4; ++m) { const int row = row0 + ai * HALF + m * 16; const size_t off = (size_t)row * DM + col0; float q = 0.f;
#pragma unroll
                for (int bj = 0; bj < 2; ++bj) {
                    f32x4 v0 = *(const f32x4*)(xb + off + bj * HALF) + acc[ai][bj][m][0], v1 = *(const f32x4*)(xb + off + bj * HALF + 4) + acc[ai][bj][m][1];
                    *(f32x4*)(P.out + off + bj * HALF) = v0; *(f32x4*)(P.out + off + bj * HALF + 4) = v1;
                    q += (v0[0] * v0[0] + v0[1] * v0[1]) + (v0[2] * v0[2] + v0[3] * v0[3]) + (v1[0] * v1[0] + v1[1] * v1[1]) + (v1[2] * v1[2] + v1[3] * v1[3]);
                    u32x4 w; w.x = cvt_pk_bf16(v0[0], v0[1]); w.y = cvt_pk_bf16(v0[2], v0[3]); w.z = cvt_pk_bf16(v1[0], v1[1]); w.w = cvt_pk_bf16(v1[2], v1[3]);
                    *(u32x4*)(P.H + off + bj * HALF) = w; }
                q += __shfl_xor(q, 16); q += __shfl_xor(q, 32);
                if (fq == 0) P.SS1[(size_t)row * 16 + u.pn * 4 + wc] = q; }
    }
};

struct Epi5 {
    Ptrs P;
    __device__ __forceinline__ bool keep(const Unit&) const { return false; }
    __device__ __forceinline__ void operator()(const Acc& acc, const Unit& u, int wr, int wc, int fr, int fq, LAS3 unsigned char* lds) const {
        asm volatile("" : "+v"(fr), "+v"(fq));
        const int cc = wc * 32 + 8 * fq, col = u.pn * 128 + cc;
        const bool smp = u.pm >= 256; const int j16 = u.pm & 15;
        LAS3 float* bnd = (LAS3 float*)(lds + BND_OFF);
        LAS3 float* rsb = (LAS3 float*)(lds + BND_OFF + 4096) + 8;
        LAS3 float* cw = (LAS3 float*)(lds + BND_OFF + 5376);
        { const int t = threadIdx.x;
          if (t < 256) { const f32x4* sp = (const f32x4*)(P.SS1 + (size_t)(u.pm * BM + t) * 16); const f32x4 s = (sp[0] + sp[1]) + (sp[2] + sp[3]);
              rsb[t] = 1.0f / sqrtf(((s[0] + s[1]) + (s[2] + s[3])) * (1.0f / DM) + EPS); }
          const int k = t >> 7, c = t & 127; cw[t] = k < 3 ? P.w_conv[k * DFF + u.pn * 128 + c] : P.b_conv[u.pn * 128 + c]; }
        asm volatile("s_waitcnt lgkmcnt(0)" ::: "memory"); __builtin_amdgcn_s_barrier(); asm volatile("" ::: "memory");
        if (fr >= 14) {
#pragma unroll
            for (int ai = 0; ai < 2; ++ai) { const int rb = 2 * ai + wr; const float rsm = rsb[rb * 64 + 48 + fr];
#pragma unroll
                for (int n = 0; n < 2; ++n) { const f32x4 v = acc[ai][0][3][n] * rsm;
                    *(LAS3 f32x4*)(bnd + (rb * 2 + (fr - 14)) * 128 + cc + 4 * n) = v;
                    if (rb == 3) { *(f32x4*)(P.TAIL + ((size_t)u.pm * 2 + (fr - 14)) * DFF + col + 4 * n) = v;
                        if (!smp && j16 == 15) *(f32x4*)(P.out + O_NCP + ((size_t)(u.pm >> 4) * 2 + (fr - 14)) * DFF + col + 4 * n) = v; }
                    if (smp) *(f32x4*)(P.out + O_NCS + ((size_t)((u.pm - 256) * 4 + rb) * 2 + (fr - 14)) * DFF + col + 4 * n) = v; } }
        }
        asm volatile("s_waitcnt lgkmcnt(0)" ::: "memory"); __builtin_amdgcn_s_barrier(); asm volatile("" ::: "memory");
#pragma unroll
        for (int n = 0; n < 2; ++n) {
#pragma unroll
            for (int ai = 0; ai < 2; ++ai) { const int rb = 2 * ai + wr;
#pragma unroll
                for (int m = 0; m < 4; ++m) { const int rl = rb * 64 + m * 16 + fr, row = u.pm * BM + rl; float g4[4];
                    const f32x4 w0 = *(const LAS3 f32x4*)(cw + cc + 4 * n), w1 = *(const LAS3 f32x4*)(cw + 128 + cc + 4 * n), w2 = *(const LAS3 f32x4*)(cw + 256 + cc + 4 * n), bc = *(const LAS3 f32x4*)(cw + 384 + cc + 4 * n);
                    const float rsm = rsb[rl], rs1 = rsb[rl - 1], rs2 = rsb[rl - 2];
                    f32x4 B2 = (f32x4){0.f, 0.f, 0.f, 0.f}, B1 = B2;
                    if (m == 0) {
                        if (smp) { const size_t cb = (size_t)((u.pm - 256) * 4 + rb) * 2 * DFF + col + 4 * n; B2 = *(const f32x4*)(P.cache_conv + cb); B1 = *(const f32x4*)(P.cache_conv + cb + DFF); }
                        else if (rb != 0) { B2 = *(const LAS3 f32x4*)(bnd + ((rb - 1) * 2 + 0) * 128 + cc + 4 * n); B1 = *(const LAS3 f32x4*)(bnd + ((rb - 1) * 2 + 1) * 128 + cc + 4 * n); } }
#pragma unroll
                    for (int j = 0; j < 4; ++j) { const float ar = acc[ai][0][m][n][j], a = ar * rsm;
                        const float d1r = dpp<0x121>(ar), d2r = dpp<0x122>(ar);
                        float p1, p2;
                        if (m == 0) { p1 = (fr == 0) ? B1[j] : d1r * rs1; p2 = (fr == 0) ? B2[j] : ((fr == 1) ? B1[j] : d2r * rs2); }
                        else { const float ap = acc[ai][0][m > 0 ? m - 1 : 0][n][j]; const float d1p = dpp<0x121>(ap), d2p = dpp<0x122>(ap);
                            p1 = ((fr == 0) ? d1p : d1r) * rs1; p2 = ((fr < 2) ? d2p : d2r) * rs2; }
                        const float c = bc[j] + w0[j] * p2 + w1[j] * p1 + w2[j] * a;
                        g4[j] = gelu_t(c) * (acc[ai][1][m][n][j] * rsm); }
                    u32x2 w; w.x = cvt_pk_bf16(g4[0], g4[1]); w.y = cvt_pk_bf16(g4[2], g4[3]);
                    *(u32x2*)(P.G + (size_t)row * DFF + col + 4 * n) = w;
                    if (m == 0 && rb == 0 && fr < 2 && !smp && j16 != 0) {
                        *(f32x4*)(P.HALOA + ((size_t)u.pm * 2 + fr) * DFF + col + 4 * n) = acc[ai][0][0][n] * rsm;
                        *(f32x4*)(P.HALOV + ((size_t)u.pm * 2 + fr) * DFF + col + 4 * n) = acc[ai][1][0][n] * rsm; }
                    asm volatile("" ::: "memory"); __builtin_amdgcn_sched_barrier(0);
                }
            }
        }
    }
};

struct Epi6 {
    Ptrs P;
    __device__ __forceinline__ bool keep(const Unit&) const { return false; }
    __device__ __forceinline__ void operator()(Acc& acc, const Unit& u, int wr, int wc, int fr, int fq, LAS3 unsigned char*) const {
        asm volatile("" : "+v"(fr), "+v"(fq));
        const int row0 = u.pm * BM + wr * 64 + fr, col0 = u.pn * BM + wc * 32 + 8 * fq;
#pragma unroll
        for (int ai = 0; ai < 2; ++ai)
#pragma unroll
            for (int m = 0; m < 4; ++m) { float* yp = P.out + (size_t)(row0 + ai * HALF + m * 16) * DM + col0;
#pragma unroll
                for (int bj = 0; bj < 2; ++bj) { const f32x4 v0 = *(const f32x4*)(yp + bj * HALF) + acc[ai][bj][m][0], v1 = *(const f32x4*)(yp + bj * HALF + 4) + acc[ai][bj][m][1];
                    *(f32x4*)(yp + bj * HALF) = v0; *(f32x4*)(yp + bj * HALF + 4) = v1; } }
    }
};
}

__device__ __forceinline__ void transpose_item(const float* W, int K, int N, bf16_t* WT, LAS3 float* scr, int item, int lane, const float* kscale, int mode) {
    const int nblk = N / 32, kb = item / nblk, nb = item % nblk, k0 = 64 * kb, n0 = 32 * nb;
#pragma unroll 8
    for (int i = 0; i < 32; ++i) { const int kk = 2 * i + (lane >> 5); float w = W[(size_t)(k0 + kk) * N + n0 + (lane & 31)]; if (kscale) w *= kscale[k0 + kk]; scr[kk * 33 + (lane & 31)] = w; }
    asm volatile("s_waitcnt lgkmcnt(0)" ::: "memory");
    int r0 = n0;
    if (mode == 1) { const int hv = n0 >= DFF ? 1 : 0, nn = n0 - hv * DFF; r0 = (nn >> 7) * 256 + hv * 128 + (nn & 127); }
    const int c = lane & 7;
#pragma unroll
    for (int j = 0; j < 4; ++j) { const int n = (lane >> 3) + 8 * j; const LAS3 float* s = scr + (8 * c) * 33 + n;
        u32x4 o; o.x = cvt_pk_bf16(s[0 * 33], s[1 * 33]); o.y = cvt_pk_bf16(s[2 * 33], s[3 * 33]); o.z = cvt_pk_bf16(s[4 * 33], s[5 * 33]); o.w = cvt_pk_bf16(s[6 * 33], s[7 * 33]);
        *(u32x4*)(WT + (size_t)(r0 + n) * K + k0 + 8 * c) = o; }
    asm volatile("s_waitcnt lgkmcnt(0)" ::: "memory");
}

__device__ __forceinline__ void spatial_unit(LAS3 unsigned char* lds, const Ptrs& P, int su, int& g_loaded) {
    const int tid = threadIdx.x, wid = __builtin_amdgcn_readfirstlane(tid >> 6), lane = tid & 63, fr = lane & 15, fq = lane >> 4;
    const int g = su & 7, ck = su >> 3; const bool smp = ck >= 512;
    const int nrows = smp ? 64 : 128, row0 = smp ? MP + (ck - 512) * 64 : ck * 128;
    LAS3 unsigned char* WsB = lds;
    LAS3 unsigned char* VnT = lds + 34816;
    if (g != g_loaded) {
#pragma unroll
        for (int i = 0; i < 8; ++i) { const int e = tid + 512 * i, t = e >> 5, s4 = (e & 31) * 4;
            f32x4 w = *(const f32x4*)(P.w_s + ((size_t)g * 128 + t) * 128 + s4);
            if (t < 64 && s4 >= 64) w = (f32x4){0.f, 0.f, 0.f, 0.f};
            u32x2 o; o.x = cvt_pk_bf16(w[0], w[1]); o.y = cvt_pk_bf16(w[2], w[3]);
            *(LAS3 u32x2*)(WsB + t * 272 + s4 * 2) = o; }
        g_loaded = g;
    }
    { const int srow = tid >> 2, c0 = (tid & 3) * 32;
      if (srow < nrows) { const int row = row0 + srow;
        const f32x4* sp = (const f32x4*)(P.STATS + (size_t)row * 32); float s = 0.f, q = 0.f;
#pragma unroll
        for (int i = 0; i < 8; ++i) { const f32x4 v = sp[i]; s += v[0] + v[2]; q += v[1] + v[3]; }
        const float mean = s * (1.0f / DM), var = fmaxf(q * (1.0f / DM) - mean * mean, 0.f), rstd = 1.0f / sqrtf(var + EPS);
#pragma unroll
        for (int i = 0; i < 4; ++i) { const int c = c0 + 8 * i; const u32x4 gv = *(const u32x4*)(P.VG + (size_t)row * DM + g * 128 + c);
            const float x[8] = {bf_lo(gv.x), bf_hi(gv.x), bf_lo(gv.y), bf_hi(gv.y), bf_lo(gv.z), bf_hi(gv.z), bf_lo(gv.w), bf_hi(gv.w)};
            const f32x4 lg0 = *(const f32x4*)(P.ln_v_g + g * 128 + c), lg1 = *(const f32x4*)(P.ln_v_g + g * 128 + c + 4), lb0 = *(const f32x4*)(P.ln_v_b + g * 128 + c), lb1 = *(const f32x4*)(P.ln_v_b + g * 128 + c + 4);
            float vn[8];
#pragma unroll
            for (int e = 0; e < 8; ++e) vn[e] = (x[e] - mean) * rstd * (e < 4 ? lg0[e & 3] : lg1[e & 3]) + (e < 4 ? lb0[e & 3] : lb1[e & 3]);
            if (smp) { float* o = P.out + O_NGV + (size_t)(row - MP) * DM + g * 128 + c; *(f32x4*)o = (f32x4){vn[0], vn[1], vn[2], vn[3]}; *(f32x4*)(o + 4) = (f32x4){vn[4], vn[5], vn[6], vn[7]}; }
#pragma unroll
            for (int e = 0; e < 8; e += 2) { const unsigned w = cvt_pk_bf16(vn[e], vn[e + 1]);
                *(LAS3 unsigned short*)(VnT + (c + e) * 272 + srow * 2) = (unsigned short)(w & 0xffffu); *(LAS3 unsigned short*)(VnT + (c + e + 1) * 272 + srow * 2) = (unsigned short)(w >> 16); } }
      } }
    __syncthreads();
    if (wid * 16 < nrows) {
        f32x4 acc[8];
#pragma unroll
        for (int nb = 0; nb < 8; ++nb) acc[nb] = (f32x4){0.f, 0.f, 0.f, 0.f};
        const int nks = wid < 4 ? 2 : 4;
        for (int ks = 0; ks < nks; ++ks) { const bf16x8 af = *(const LAS3 bf16x8*)(WsB + (wid * 16 + fr) * 272 + (32 * ks + 8 * fq) * 2);
#pragma unroll
            for (int nb = 0; nb < 8; ++nb) { const int c = 32 * (nb >> 1) + 8 * (fr >> 2) + 4 * (nb & 1) + (fr & 3);
                const bf16x8 bfv = *(const LAS3 bf16x8*)(VnT + c * 272 + (32 * ks + 8 * fq) * 2);
                acc[nb] = __builtin_amdgcn_mfma_f32_16x16x32_bf16(bfv, af, acc[nb], 0, 0, 0); } }
        const int t = wid * 16 + fr, row = row0 + t; const float bs = P.b_s[g * 128 + t];
#pragma unroll
        for (int p = 0; p < 4; ++p) { bf16_t* up = P.U + (size_t)row * DM + g * 128 + 32 * p + 8 * fq; const u32x4 uv = *(const u32x4*)up;
            const float x[8] = {bf_lo(uv.x), bf_hi(uv.x), bf_lo(uv.y), bf_hi(uv.y), bf_lo(uv.z), bf_hi(uv.z), bf_lo(uv.w), bf_hi(uv.w)}; float o[8];
#pragma unroll
            for (int e = 0; e < 8; ++e) o[e] = x[e] * (acc[2 * p + (e >> 2)][e & 3] + bs);
            u32x4 w; w.x = cvt_pk_bf16(o[0], o[1]); w.y = cvt_pk_bf16(o[2], o[3]); w.z = cvt_pk_bf16(o[4], o[5]); w.w = cvt_pk_bf16(o[6], o[7]);
            *(u32x4*)up = w; }
    }
    __syncthreads();
}

__device__ __forceinline__ void attn_unit(LAS3 unsigned char* lds, const Ptrs& P, int au) {
    const int tid = threadIdx.x, wid = __builtin_amdgcn_readfirstlane(tid >> 6), lane = tid & 63, l31 = lane & 31, hi = lane >> 5;
    const int hk = au & 3, ch = au >> 2; const bool smp = ch >= 1024;
    const int qrow0 = ch * 64, kmin = smp ? 0 : max(0, 128 - 64 * (ch & 63));
    LAS3 unsigned char* Ks = lds;
    LAS3 unsigned char* VT = lds + 27648;
#pragma unroll
    for (int i = 0; i < 3; ++i) { const int e = tid + 512 * i, kj = e >> 3, part = e & 7;
        u32x4 kv = (u32x4){0u, 0u, 0u, 0u}, vv = kv;
        if (smp && kj < 128) { const size_t o = (((size_t)(ch - 1024) * 128 + kj) * 4 + hk) * 64 + part * 8;
            const f32x4 k0 = *(const f32x4*)(P.cache_k + o), k1 = *(const f32x4*)(P.cache_k + o + 4), v0 = *(const f32x4*)(P.cache_v + o), v1 = *(const f32x4*)(P.cache_v + o + 4);
            kv.x = cvt_pk_bf16(k0[0], k0[1]); kv.y = cvt_pk_bf16(k0[2], k0[3]); kv.z = cvt_pk_bf16(k1[0], k1[1]); kv.w = cvt_pk_bf16(k1[2], k1[3]);
            vv.x = cvt_pk_bf16(v0[0], v0[1]); vv.y = cvt_pk_bf16(v0[2], v0[3]); vv.z = cvt_pk_bf16(v1[0], v1[1]); vv.w = cvt_pk_bf16(v1[2], v1[3]); }
        else if (kj >= kmin) { const size_t o = (size_t)(qrow0 - 128 + kj) * 256 + hk * 64 + part * 8; kv = *(const u32x4*)(P.KB + o); vv = *(const u32x4*)(P.VB + o); }
        *(LAS3 u32x4*)(Ks + kj * 144 + part * 16) = kv;
        const unsigned vw[4] = {vv.x, vv.y, vv.z, vv.w};
#pragma unroll
        for (int x = 0; x < 4; ++x) { *(LAS3 unsigned short*)(VT + (part * 8 + 2 * x) * 400 + kj * 2) = (unsigned short)(vw[x] & 0xffffu); *(LAS3 unsigned short*)(VT + (part * 8 + 2 * x + 1) * 400 + kj * 2) = (unsigned short)(vw[x] >> 16); } }
    const int h = hk * 4 + (wid >> 1), qi = 32 * (wid & 1) + l31;
    bf16_t* qp = P.Q + (size_t)(qrow0 + qi) * DM + h * 64;
    bf16x8 qf[4];
#pragma unroll
    for (int s = 0; s < 4; ++s) qf[s] = *(const bf16x8*)(qp + 16 * s + 8 * hi);
    const float slope = exp2f(-0.5f * (float)(h + 1)), sink = P.sinks[h];
    __syncthreads();
    f32x16 st[6];
#pragma unroll
    for (int kb = 0; kb < 6; ++kb) { f32x16 a;
#pragma unroll
        for (int r = 0; r < 16; ++r) a[r] = 0.f;
#pragma unroll
        for (int s = 0; s < 4; ++s) { const bf16x8 kf = *(const LAS3 bf16x8*)(Ks + (32 * kb + l31) * 144 + (16 * s + 8 * hi) * 2); a = __builtin_amdgcn_mfma_f32_32x32x16_bf16(kf, qf[s], a, 0, 0, 0); }
        st[kb] = a; }
    float mx = -1e30f;
#pragma unroll
    for (int kb = 0; kb < 6; ++kb)
#pragma unroll
        for (int r = 0; r < 16; ++r) { const int key = 32 * kb + (r & 3) + 8 * (r >> 2) + 4 * hi; const int d = qi + 128 - key; const float dist = (float)(d < 0 ? -d : d);
            float s = st[kb][r] - slope * dist; if (key < kmin) s = -1e30f; st[kb][r] = s; mx = fmaxf(mx, s); }
    mx = fmaxf(mx, __shfl_xor(mx, 32)); mx = fmaxf(mx, sink);
    float sum = 0.f;
#pragma unroll
    for (int kb = 0; kb < 6; ++kb)
#pragma unroll
        for (int r = 0; r < 16; ++r) { const float e = __builtin_amdgcn_exp2f((st[kb][r] - mx) * 1.4426950409f); st[kb][r] = e; sum += e; }
    sum += __shfl_xor(sum, 32);
    const float inv = 1.0f / (sum + __builtin_amdgcn_exp2f((sink - mx) * 1.4426950409f));
    f32x16 o0, o1;
#pragma unroll
    for (int r = 0; r < 16; ++r) { o0[r] = 0.f; o1[r] = 0.f; }
#pragma unroll
    for (int kb = 0; kb < 6; ++kb)
#pragma unroll
        for (int s2 = 0; s2 < 2; ++s2) {
            u32x4 pw; pw.x = cvt_pk_bf16(st[kb][8 * s2 + 0], st[kb][8 * s2 + 1]); pw.y = cvt_pk_bf16(st[kb][8 * s2 + 2], st[kb][8 * s2 + 3]);
            pw.z = cvt_pk_bf16(st[kb][8 * s2 + 4], st[kb][8 * s2 + 5]); pw.w = cvt_pk_bf16(st[kb][8 * s2 + 6], st[kb][8 * s2 + 7]);
            const bf16x8 pf = __builtin_bit_cast(bf16x8, pw);
            const int ko = (32 * kb + 16 * s2 + 4 * hi) * 2;
            { const u32x2 a = *(const LAS3 u32x2*)(VT + l31 * 400 + ko), b = *(const LAS3 u32x2*)(VT + l31 * 400 + ko + 16);
              const bf16x8 vf = __builtin_bit_cast(bf16x8, ((u32x4){a.x, a.y, b.x, b.y})); o0 = __builtin_amdgcn_mfma_f32_32x32x16_bf16(vf, pf, o0, 0, 0, 0); }
            { const u32x2 a = *(const LAS3 u32x2*)(VT + (32 + l31) * 400 + ko), b = *(const LAS3 u32x2*)(VT + (32 + l31) * 400 + ko + 16);
              const bf16x8 vf = __builtin_bit_cast(bf16x8, ((u32x4){a.x, a.y, b.x, b.y})); o1 = __builtin_amdgcn_mfma_f32_32x32x16_bf16(vf, pf, o1, 0, 0, 0); }
        }
#pragma unroll
    for (int rq = 0; rq < 4; ++rq) {
        u32x2 w0; w0.x = cvt_pk_bf16(o0[4 * rq] * inv, o0[4 * rq + 1] * inv); w0.y = cvt_pk_bf16(o0[4 * rq + 2] * inv, o0[4 * rq + 3] * inv);
        u32x2 w1; w1.x = cvt_pk_bf16(o1[4 * rq] * inv, o1[4 * rq + 1] * inv); w1.y = cvt_pk_bf16(o1[4 * rq + 2] * inv, o1[4 * rq + 3] * inv);
        *(u32x2*)(qp + 8 * rq + 4 * hi) = w0; *(u32x2*)(qp + 32 + 8 * rq + 4 * hi) = w1; }
    __syncthreads();
}

#define XB_TMO      128
#define XB_XCNT(j)  (256  + 64 * (j))
#define XB_XSUB(j)  (1280 + 64 * (j))
#define XB_XGEN(j)  (2304 + 64 * (j))
#define XB_TOP      3328
#define XB_TOPGEN   3392
#define XCD_BAR_WORDS 3456
#define XB_SPIN_CAP (1u << 18)
__device__ __forceinline__ unsigned xb_ld(unsigned* p)              { return __hip_atomic_load(p, __ATOMIC_RELAXED, __HIP_MEMORY_SCOPE_AGENT); }
__device__ __forceinline__ unsigned xb_add(unsigned* p, unsigned v) { return __hip_atomic_fetch_add(p, v, __ATOMIC_RELAXED, __HIP_MEMORY_SCOPE_AGENT); }
__device__ __forceinline__ unsigned xb_xcc_id() { return (unsigned)__builtin_amdgcn_s_getreg((3 << 11) | 20) & 0xFu; }
#define XB_SPIN(cond, bar) do { unsigned _sp = 0; while (cond) { __builtin_amdgcn_s_sleep(1); \
    if ((++_sp & 255u) == 0u) { if (xb_ld(&(bar)[XB_TMO])) break; if (_sp > XB_SPIN_CAP) { atomicAdd(&(bar)[XB_TMO], 1u); break; } } } } while (0)
struct XcdBarrier { unsigned* bar; unsigned x; volatile LAS3 unsigned* st; };
__device__ __forceinline__ XcdBarrier xcd_barrier_post(unsigned* bar, volatile LAS3 unsigned* st) {
    XcdBarrier b; b.bar = bar; b.x = xb_xcc_id(); b.st = st;
    if (threadIdx.x == 0) (void)xb_add(&bar[XB_XCNT(b.x)], 1u);
    return b;
}
__device__ __forceinline__ void xcd_barrier_complete(unsigned* bar, unsigned x, unsigned& nloc, unsigned& nx) {
    const unsigned G = gridDim.x * gridDim.y * gridDim.z;
    unsigned sum, cnt, mine, sp = 0u;
    for (;;) {
        sum = 0u; cnt = 0u; mine = 0u;
#pragma unroll
        for (unsigned j = 0; j < 16; ++j) { const unsigned c = xb_ld(&bar[XB_XCNT(j)]); sum += c; cnt += (c > 0u) ? 1u : 0u; mine = (j == x) ? c : mine; }
        if (sum == G) break;
        __builtin_amdgcn_s_sleep(1);
        if ((++sp & 255u) == 0u) { if (xb_ld(&bar[XB_TMO])) break; if (sp > XB_SPIN_CAP) { atomicAdd(&bar[XB_TMO], 1u); break; } }
    }
    nloc = mine > 0u ? mine : 1u; nx = cnt > 0u ? cnt : 1u;
}
__device__ __forceinline__ void xcd_barrier(const XcdBarrier& b) {
    asm volatile("s_waitcnt vmcnt(0)" ::: "memory");
    __syncthreads();
    if (threadIdx.x == 0) {
        unsigned* bar = b.bar;
        __builtin_amdgcn_s_waitcnt(0);
        unsigned nloc = b.st[0], nx = b.st[1];
        if (nloc == 0u) { xcd_barrier_complete(bar, b.x, nloc, nx); b.st[0] = nloc; b.st[1] = nx; }
        const unsigned old = xb_add(&bar[XB_XSUB(b.x)], 1u);
        const unsigned gen = old / nloc;
        if (old + 1u == (gen + 1u) * nloc) {
            __builtin_amdgcn_fence(__ATOMIC_RELEASE, "agent");
            asm volatile("s_waitcnt vmcnt(0)" ::: "memory");
            const unsigned og = xb_add(&bar[XB_TOP], 1u);
            const unsigned tg = og / nx;
            if (og + 1u == (tg + 1u) * nx) xb_add(&bar[XB_TOPGEN], 1u);
            else XB_SPIN(xb_ld(&bar[XB_TOPGEN]) == tg, bar);
            __builtin_amdgcn_fence(__ATOMIC_ACQUIRE, "agent");
            xb_add(&bar[XB_XGEN(b.x)], 1u);
            asm volatile("s_waitcnt vmcnt(0)" ::: "memory");
        } else {
            XB_SPIN(xb_ld(&bar[XB_XGEN(b.x)]) == gen, bar);
            __builtin_amdgcn_fence(__ATOMIC_ACQUIRE, "agent");
            asm volatile("s_waitcnt vmcnt(0)" ::: "memory");
        }
    }
    __syncthreads();
}

struct Args { const float* in[21]; float* out; unsigned char* ws; int ph_lo, ph_hi; };
constexpr int N_PHASES = 9;

__global__ void __launch_bounds__(512, 2) mk_fwd(Args args) {
    extern __shared__ __attribute__((aligned(16))) unsigned char lds_raw[];
    LAS3 unsigned char* lds = (LAS3 unsigned char*)lds_raw;
    const int tid = threadIdx.x, lane = tid & 63, wave = __builtin_amdgcn_readfirstlane(tid >> 6);
    const int G = gridDim.x, bx = blockIdx.x;
    Ptrs P;
    P.xp = args.in[0]; P.xs = args.in[1]; P.cache_k = args.in[2]; P.cache_v = args.in[3]; P.cache_conv = args.in[4]; P.ln_mix_g = args.in[5]; P.w_in = args.in[6]; P.ln_v_g = args.in[7];
    P.ln_v_b = args.in[8]; P.w_s = args.in[9]; P.b_s = args.in[10]; P.sinks = args.in[11]; P.w_pa = args.in[12]; P.w_pb = args.in[13]; P.w_o = args.in[14]; P.ln_ffn_g = args.in[15];
    P.w_up = args.in[16]; P.w_conv = args.in[17]; P.b_conv = args.in[18]; P.w_down = args.in[19]; P.ln_final_g = args.in[20];
    P.out = args.out; unsigned char* ws = args.ws;
    P.WIN = (bf16_t*)(ws + WS_WIN); P.WUP = (bf16_t*)(ws + WS_WUP); P.WDN = (bf16_t*)(ws + WS_WDN); P.WPA = (bf16_t*)(ws + WS_WPA); P.WPB = (bf16_t*)(ws + WS_WPB); P.WO = (bf16_t*)(ws + WS_WO);
    P.H = (bf16_t*)(ws + WS_H); P.U = (bf16_t*)(ws + WS_U); P.VG = (bf16_t*)(ws + WS_VG); P.Q = (bf16_t*)(ws + WS_Q); P.GA = (bf16_t*)(ws + WS_GA); P.GB = (bf16_t*)(ws + WS_GB);
    P.KB = (bf16_t*)(ws + WS_K); P.VB = (bf16_t*)(ws + WS_V); P.G = (bf16_t*)(ws + WS_G); P.MG = (bf16_t*)(ws + WS_MG);
    P.STATS = (float*)(ws + WS_STATS); P.SS1 = (float*)(ws + WS_SS1); P.HALOA = (float*)(ws + WS_HALOA); P.HALOV = (float*)(ws + WS_HALOV); P.TAIL = (float*)(ws + WS_TAIL);
    const int lo = args.ph_lo, hi = args.ph_hi;
    if (hi > 1000) cg::this_grid().sync();
    volatile LAS3 unsigned* bst = (volatile LAS3 unsigned*)(lds + BND_OFF + 8192);
    if (tid == 0) { bst[0] = 0u; bst[1] = 0u; }
    __syncthreads();
    const XcdBarrier bar = xcd_barrier_post((unsigned*)ws, bst);
#ifndef PH_MASK
#define PH_MASK 0x1ff
#endif
#define IN(k) (((PH_MASK >> (k)) & 1) && lo <= (k) && (k) < hi)
#define SEAM(k) do { if (IN(k) && IN((k) + 1)) xcd_barrier(bar); } while (0)
    const int gw = bx * 8 + wave, NGW = G * 8;

    if (IN(0)) {
        LAS3 float* scr = (LAS3 float*)(lds + wave * 16384);
        constexpr int I_IN = (DM / 64) * (NIN / 32), I_SQ = (DM / 64) * (DM / 32), I_DN = (DFF / 64) * (DM / 32);
        constexpr int NITEMS = 2 * I_IN + 3 * I_SQ + I_DN;
        for (int it = gw; it < NITEMS; it += NGW) {
            int r = it;
            if (r < I_IN) { transpose_item(P.w_in, DM, NIN, P.WIN, scr, r, lane, nullptr, 0); continue; } r -= I_IN;
            if (r < I_IN) { transpose_item(P.w_up, DM, NIN, P.WUP, scr, r, lane, P.ln_ffn_g, 1); continue; } r -= I_IN;
            if (r < I_SQ) { transpose_item(P.w_pa, DM, DM, P.WPA, scr, r, lane, nullptr, 0); continue; } r -= I_SQ;
            if (r < I_SQ) { transpose_item(P.w_pb, DM, DM, P.WPB, scr, r, lane, nullptr, 0); continue; } r -= I_SQ;
            if (r < I_SQ) { transpose_item(P.w_o, DM, DM, P.WO, scr, r, lane, nullptr, 0); continue; } r -= I_SQ;
            transpose_item(P.w_down, DFF, DM, P.WDN, scr, r, lane, nullptr, 0);
        }
        f32x4 gm[4];
#pragma unroll
        for (int j = 0; j < 4; ++j) gm[j] = ((const f32x4*)P.ln_mix_g)[lane + 64 * j];
        for (int m = gw; m < M; m += NGW) {
            const float* xr = m < MP ? P.xp + (size_t)m * DM : P.xs + (size_t)(m - MP) * DM;
            f32x4 v[4]; float s = 0.f;
#pragma unroll
            for (int j = 0; j < 4; ++j) { v[j] = ((const f32x4*)xr)[lane + 64 * j]; s += (v[j][0] * v[j][0] + v[j][1] * v[j][1]) + (v[j][2] * v[j][2] + v[j][3] * v[j][3]); }
            const float rstd = 1.0f / sqrtf(wave_sum(s) * (1.0f / DM) + EPS);
            u32x2* o8 = (u32x2*)(P.H + (size_t)m * DM) + lane;
#pragma unroll
            for (int j = 0; j < 4; ++j) { u32x2 w; w.x = cvt_pk_bf16(v[j][0] * rstd * gm[j][0], v[j][1] * rstd * gm[j][1]); w.y = cvt_pk_bf16(v[j][2] * rstd * gm[j][2], v[j][3] * rstd * gm[j][3]); o8[64 * j] = w; }
        }
    }
    SEAM(0);
    if (IN(1)) {
        pg8::Gemm g{P.H, P.WIN, P.H, P.WIN, DM}; pg8::TileOrder S; S.init(M, NIN, G, bx, 1); pg8::Epi1 E{P};
        pg8::gemm_phase(lds, g, S, E);
    }
    SEAM(1);
    if (IN(2)) {
        int g_loaded = -1;
        for (int su = bx; su < (512 + 32) * 8; su += G) spatial_unit(lds, P, su, g_loaded);
        for (int au = bx; au < (1024 + 32) * 4; au += G) attn_unit(lds, P, au);
    }
    SEAM(2);
    if (IN(3)) {
        pg8::Gemm g{P.U, P.WPA, P.Q, P.WPB, DM}; pg8::TileOrder S; S.init(M, DM, G, bx, 2); pg8::Epi3 E{P};
        pg8::gemm_phase(lds, g, S, E);
    }
    SEAM(3);
    if (IN(4)) {
        pg8::Gemm g{P.MG, P.WO, P.MG, P.WO, DM}; pg8::TileOrder S; S.init(M, DM, G, bx, 1); pg8::Epi4 E{P};
        pg8::gemm_phase(lds, g, S, E);
    }
    SEAM(4);
    if (IN(5)) {
        pg8::Gemm g{P.H, P.WUP, P.H, P.WUP, DM}; pg8::TileOrder S; S.init(M, NIN, G, bx, 1); pg8::Epi5 E{P};
        pg8::gemm_phase(lds, g, S, E);
    }
    SEAM(5);
    if (IN(6)) {
        const int total = 256 * DFF;
        for (int e = bx * 512 + tid; e < total; e += G * 512) { const int pm = e / DFF, col = e - pm * DFF; if ((pm & 15) == 0) continue;
            const float a0 = P.HALOA[((size_t)pm * 2) * DFF + col], a1 = P.HALOA[((size_t)pm * 2 + 1) * DFF + col], v0 = P.HALOV[((size_t)pm * 2) * DFF + col], v1 = P.HALOV[((size_t)pm * 2 + 1) * DFF + col];
            const float p2 = P.TAIL[((size_t)(pm - 1) * 2) * DFF + col], p1 = P.TAIL[((size_t)(pm - 1) * 2 + 1) * DFF + col];
            const float w0 = P.w_conv[col], w1 = P.w_conv[DFF + col], w2 = P.w_conv[2 * DFF + col], bc = P.b_conv[col];
            const float c0 = bc + w0 * p2 + w1 * p1 + w2 * a0, c1 = bc + w0 * p1 + w1 * a0 + w2 * a1;
            const unsigned w = cvt_pk_bf16(gelu_t(c0) * v0, gelu_t(c1) * v1);
            P.G[(size_t)(pm * 256) * DFF + col] = (bf16_t)(w & 0xffffu); P.G[(size_t)(pm * 256 + 1) * DFF + col] = (bf16_t)(w >> 16); }
    }
    SEAM(6);
    if (IN(7)) {
        pg8::Gemm g{P.G, P.WDN, P.G, P.WDN, DFF}; pg8::TileOrder S; S.init(M, DM, G, bx, 1); pg8::Epi6 E{P};
        pg8::gemm_phase(lds, g, S, E);
    }
    SEAM(7);
    if (IN(8)) {
        f32x4 gm[4];
#pragma unroll
        for (int j = 0; j < 4; ++j) gm[j] = ((const f32x4*)P.ln_final_g)[lane + 64 * j];
        for (int m = gw; m < M; m += NGW) {
            f32x4* yr = (f32x4*)(P.out + (size_t)m * DM) + lane;
            f32x4 v[4]; float s = 0.f;
#pragma unroll
            for (int j = 0; j < 4; ++j) { v[j] = yr[64 * j]; s += (v[j][0] * v[j][0] + v[j][1] * v[j][1]) + (v[j][2] * v[j][2] + v[j][3] * v[j][3]); }
            const float rstd = 1.0f / sqrtf(wave_sum(s) * (1.0f / DM) + EPS);
#pragma unroll
            for (int j = 0; j < 4; ++j) yr[64 * j] = v[j] * rstd * gm[j];
        }
    }
#undef IN
#undef SEAM
}

extern "C" void kernel_launch(void* const* d_in, const int* in_sizes, int n_in, void* d_out, int out_size, void* d_ws, size_t ws_size, hipStream_t stream) {
    static int grid = 0;
    if (grid == 0) {
        if (n_in != 21 || in_sizes[0] != MP * DM || (size_t)out_size != O_END || ws_size < WS_END) {
            fprintf(stderr, "kernel_launch: shape mismatch: n_in %d in0 %d out %d ws %zu (need %zu)\n", n_in, n_in > 0 ? in_sizes[0] : -1, out_size, ws_size, (size_t)WS_END); grid = -1; return; }
        int dev = 0, cus = 0, per_cu = 0;
        (void)hipGetDevice(&dev); (void)hipDeviceGetAttribute(&cus, hipDeviceAttributeMultiprocessorCount, dev);
        if (hipFuncSetAttribute((const void*)mk_fwd, hipFuncAttributeMaxDynamicSharedMemorySize, LDS_BYTES) != hipSuccess) { fprintf(stderr, "kernel_launch: hipFuncSetAttribute failed\n"); grid = -1; return; }
        if (hipOccupancyMaxActiveBlocksPerMultiprocessor(&per_cu, (const void*)mk_fwd, 512, LDS_BYTES) != hipSuccess || per_cu < 1) { fprintf(stderr, "kernel_launch: occupancy query says %d\n", per_cu); per_cu = 1; }
        (void)hipGetLastError();
        grid = cus * 1;
        fprintf(stderr, "kernel_launch: cus %d per_cu %d grid %d\n", cus, per_cu, grid);
    }
    if (grid < 0) return;
    if (hipMemsetAsync(d_ws, 0, 16384, stream) != hipSuccess) { fprintf(stderr, "kernel_launch: memset failed\n"); return; }
    Args a{};
    for (int i = 0; i < 21; ++i) a.in[i] = (const float*)d_in[i];
    a.out = (float*)d_out; a.ws = (unsigned char*)d_ws;
#if MK_ONE_LAUNCH
    a.ph_lo = 0; a.ph_hi = N_PHASES;
    void* kargs[] = {&a};
    hipError_t e = hipLaunchCooperativeKernel((const void*)mk_fwd, dim3(grid), dim3(512), kargs, LDS_BYTES, stream);
    if (e != hipSuccess) fprintf(stderr, "kernel_launch: cooperative launch failed: %s (grid %d)\n", hipGetErrorString(e), grid);
#else
    for (int k = 0; k < N_PHASES; ++k) { a.ph_lo = k; a.ph_hi = k + 1; hipLaunchKernelGGL(mk_fwd, dim3(grid), dim3(512), LDS_BYTES, stream, a); }
#endif
}
```
